# Optimizing an MI355X kernel written in HIP

```python
import jax, jax.numpy as jnp
from jax import lax
import numpy as np

D_MODEL = 2048
BATCH = 16
SEQ = 2048
DEPTH = 1

CHUNK = 128
A_GROUPS = 8
A_GROUP_DIM = 128
A_WIDTH = A_GROUPS * A_GROUP_DIM
N_HEADS = 8
HEAD_DIM = 128
N_KV = 2
Q_WIDTH = N_HEADS * HEAD_DIM
KV_WIDTH = N_KV * HEAD_DIM
IDX_HEADS = 16
IDX_DIM = 64
TOPK_MAX = 256
Q_BLOCK = 128
D_FF = 5632
CONV_W = 3
EPS = 1e-6

kernel_name = "hybrid_gated_sgu_dsa_convffn_block"


def _col_sizes():
    return [A_WIDTH, A_WIDTH, Q_WIDTH, KV_WIDTH, KV_WIDTH,
            IDX_HEADS * IDX_DIM, IDX_DIM, IDX_HEADS, D_MODEL, D_MODEL]


def rms_norm(x, g):
    xf = x.astype(jnp.float32)
    y = xf * lax.rsqrt(jnp.mean(xf * xf, axis=-1, keepdims=True) + EPS)
    return (y * g.astype(jnp.float32)).astype(x.dtype)


def chunked_spatial_gating(u, v, v_norm_g, w_spatial, b_spatial):
    B, S, _ = v.shape
    n = S // CHUNK
    v = rms_norm(v, v_norm_g)
    vc = v.reshape(B, n, CHUNK, A_GROUPS, A_GROUP_DIM)
    causal = jnp.tril(jnp.ones((CHUNK, CHUNK), dtype=bool))
    w = jnp.where(causal[None], w_spatial, 0)
    mixed = jnp.einsum('gts,bnsgc->bntgc', w, vc) + b_spatial.T[None, None, :, :, None]
    return u * mixed.reshape(B, S, A_WIDTH)


def dsa_attention(q, k, v, q_idx, k_idx, w_idx):
    B, S = q.shape[0], q.shape[1]
    topk = min(TOPK_MAX, S // 4)
    n_blocks = S // Q_BLOCK
    rep = N_HEADS // N_KV
    key_pos = jnp.arange(S)
    k_idx_f = k_idx.astype(jnp.float32)
    idx_scale = IDX_DIM ** -0.5 * IDX_HEADS ** -0.5
    att_scale = HEAD_DIM ** -0.5

    def block(i):
        start = i * Q_BLOCK
        qb = lax.dynamic_slice_in_dim(q, start, Q_BLOCK, axis=1)
        qib = lax.dynamic_slice_in_dim(q_idx, start, Q_BLOCK, axis=1)
        wib = lax.dynamic_slice_in_dim(w_idx, start, Q_BLOCK, axis=1)
        q_pos = start + jnp.arange(Q_BLOCK)
        causal = key_pos[None, :] <= q_pos[:, None]
        logits = jnp.einsum('bthd,bsd->bths', qib.astype(jnp.float32), k_idx_f)
        score = jnp.einsum('bth,bths->bts', wib.astype(jnp.float32), jax.nn.relu(logits)) * idx_scale
        score = jnp.where(causal[None], score, -jnp.inf)
        top_val, top_idx = lax.top_k(score, topk)
        valid = top_val > -jnp.inf
        ks = jax.vmap(lambda kk, ii: kk[ii])(k, top_idx)
        vs = jax.vmap(lambda vv, ii: vv[ii])(v, top_idx)
        qg = qb.reshape(B, Q_BLOCK, N_KV, rep, HEAD_DIM)
        s = jnp.einsum('btgrd,btkgd->btgrk', qg, ks).astype(jnp.float32) * att_scale
        s = jnp.where(valid[:, :, None, None, :], s, -jnp.inf)
        p = jax.nn.softmax(s, axis=-1)
        o = jnp.einsum('btgrk,btkgd->btgrd', p.astype(vs.dtype), vs)
        return o.reshape(B, Q_BLOCK, Q_WIDTH)

    out = lax.map(block, jnp.arange(n_blocks))
    return out.transpose(1, 0, 2, 3).reshape(B, S, Q_WIDTH)


def causal_depthwise_conv(x, w, b):
    S = x.shape[1]
    xp = jnp.pad(x, ((0, 0), (CONV_W - 1, 0), (0, 0)))
    y = b + w[0] * xp[:, 0:S]
    for j in range(1, CONV_W):
        y = y + w[j] * xp[:, j:j + S]
    return y


def setup_inputs(seed: int = 0) -> dict:
    key = jax.random.key(seed)
    ks = jax.random.split(key, 20)
    n_cols = sum(_col_sizes())
    nrm = lambda k, shape, s: jax.random.normal(k, shape, jnp.float32) * s
    return {
        "x": nrm(ks[0], (BATCH, SEQ, D_MODEL), 1.0),
        "c": nrm(ks[1], (BATCH, D_MODEL), 1.0),
        "w_ada": nrm(ks[2], (D_MODEL, 6 * D_MODEL), 0.5 * D_MODEL ** -0.5),
        "b_ada": nrm(ks[3], (6 * D_MODEL,), 0.01),
        "norm1_g": 1.0 + nrm(ks[4], (D_MODEL,), 0.02),
        "w_in": nrm(ks[5], (D_MODEL, n_cols), D_MODEL ** -0.5),
        "v_norm_g": 1.0 + nrm(ks[6], (A_WIDTH,), 0.02),
        "w_spatial": nrm(ks[7], (A_GROUPS, CHUNK, CHUNK), CHUNK ** -0.5),
        "b_spatial": 1.0 + nrm(ks[8], (A_GROUPS, CHUNK), 0.1),
        "q_norm_g": 1.0 + nrm(ks[9], (HEAD_DIM,), 0.02),
        "k_norm_g": 1.0 + nrm(ks[10], (HEAD_DIM,), 0.02),
        "w_proj_a": nrm(ks[11], (A_WIDTH, D_MODEL), A_WIDTH ** -0.5),
        "w_proj_b": nrm(ks[12], (Q_WIDTH, D_MODEL), Q_WIDTH ** -0.5),
        "w_out": nrm(ks[13], (D_MODEL, D_MODEL), D_MODEL ** -0.5),
        "norm2_g": 1.0 + nrm(ks[14], (D_MODEL,), 0.02),
        "w_up": nrm(ks[15], (D_MODEL, 2 * D_FF), D_MODEL ** -0.5),
        "conv_w": nrm(ks[16], (CONV_W, 2 * D_FF), CONV_W ** -0.5),
        "conv_b": nrm(ks[17], (2 * D_FF,), 0.01),
        "w_down": nrm(ks[18], (D_FF, D_MODEL), D_FF ** -0.5),
    }


def reference(x, c, w_ada, b_ada, norm1_g, w_in, v_norm_g, w_spatial, b_spatial,
              q_norm_g, k_norm_g, w_proj_a, w_proj_b, w_out, norm2_g, w_up,
              conv_w, conv_b, w_down):
    B, S, _ = x.shape
    mod = (jax.nn.silu(c) @ w_ada + b_ada)[:, None, :]
    sh1, sc1, g1, sh2, sc2, g2 = jnp.split(mod, 6, axis=-1)
    split_pts = []
    acc = 0
    for n in _col_sizes()[:-1]:
        acc += n
        split_pts.append(acc)
    for _ in range(DEPTH):
        h = rms_norm(x, norm1_g) * (1.0 + sc1) + sh1
        proj = h @ w_in
        u, va, q, k, vb, qi, ki, wi, ga, gb = jnp.split(proj, split_pts, axis=-1)
        ya = chunked_spatial_gating(jax.nn.gelu(u), jax.nn.gelu(va), v_norm_g, w_spatial, b_spatial)
        qh = rms_norm(q.reshape(B, S, N_HEADS, HEAD_DIM), q_norm_g)
        kh = rms_norm(k.reshape(B, S, N_KV, HEAD_DIM), k_norm_g)
        vh = vb.reshape(B, S, N_KV, HEAD_DIM)
        yb = dsa_attention(qh, kh, vh, qi.reshape(B, S, IDX_HEADS, IDX_DIM), ki, wi)
        merged = jax.nn.sigmoid(ga) * (ya @ w_proj_a) + jax.nn.sigmoid(gb) * (yb @ w_proj_b)
        x = x + g1 * (merged @ w_out)
        h2 = rms_norm(x, norm2_g) * (1.0 + sc2) + sh2
        up = causal_depthwise_conv(h2 @ w_up, conv_w, conv_b)
        a, bval = jnp.split(up, 2, axis=-1)
        x = x + g2 * ((jax.nn.silu(a) * bval) @ w_down)
    return x
```

```cpp
#include <hip/hip_runtime.h>
#include <hip/hip_cooperative_groups.h>
#include <cstdio>
namespace cg = cooperative_groups;
#define MULTI_LAUNCH 1
namespace pg8 {
#define PG8_LAS __attribute__((address_space(3)))
typedef unsigned short bf16_t;
typedef short bf16x8 __attribute__((ext_vector_type(8)));
typedef float f32x4 __attribute__((ext_vector_type(4)));
typedef unsigned u32x4 __attribute__((ext_vector_type(4)));
constexpr int BM = 256, BK = 64, HALF = 128, HTB = HALF * BK * 2  , STAGE_BYTES = 8 * HTB, NXCD = 8, WGM = 8;

__host__ __device__ __forceinline__ int lds_byte(int r, int c) { const int st = (r >> 4) * 2 + (c >> 5), rr = r & 15, cc = c & 31, ob = rr * 64 + cc * 2; return st * 1024 + (ob ^ (((ob >> 9) & 1) << 5)); }
__host__ __device__ __forceinline__ void stage_rc(int b, int& R, int& C) { const int st = b / 1024, sb = b % 1024, swz = sb ^ (((sb >> 9) & 1) << 5); R = (st >> 1) * 16 + swz / 64; C = (st & 1) * 32 + (swz % 64) / 2; }
__host__ __device__ __forceinline__ int perm32(int rho) { const int n = rho >> 4, i = rho & 15; return 8 * (i >> 2) + 4 * n + (i & 3); }

struct Unit { int pm, pn; };
struct Gemm { const bf16_t* A; const bf16_t* Bt; int M, N, K; };

struct StaticOrder {
    int nM, nN, nwg, G, c;
    __host__ __device__ void init(int M, int N, int G_, int c_) { nM = M / BM; nN = N / BM; nwg = nM * nN; G = G_; c = c_; }
    __host__ __device__ bool next(int i, Unit& u) const {
        const long L = (long)i * G + c; if (L >= nwg) return false;
        int wgid = (int)L; { const int q = nwg / NXCD, r = nwg % NXCD, xcd = wgid % NXCD, off = wgid / NXCD; wgid = (xcd < r ? xcd * (q + 1) : r * (q + 1) + (xcd - r) * q) + off; }
        const int nig = WGM * nN, gid = wgid / nig, fm = gid * WGM, gsz = (nM - fm) < WGM ? (nM - fm) : WGM;
        u.pm = fm + ((wgid % nig) % gsz); u.pn = (wgid % nig) / gsz; return true;
    }
    __device__ __forceinline__ void a_ready(const Unit&) const {}
    __device__ __forceinline__ void done(const Unit&) const {}
};
__device__ __forceinline__ unsigned cvt_pk_bf16(float lo, float hi) { unsigned r; asm volatile("v_cvt_pk_bf16_f32 %0, %1, %2" : "=v"(r) : "v"(lo), "v"(hi)); return r; }

template <class Epi, class Sched, bool STAMP = false>
__device__ __forceinline__ void gemm_phase(PG8_LAS unsigned char* lds, const Gemm g, const Sched& S, const Epi& E, unsigned long long* stamps) {
    const int tid = threadIdx.x, wid = __builtin_amdgcn_readfirstlane(tid >> 6), lane = tid & 63, wr = wid >> 2, wc = wid & 3, fr = lane & 15, fq = lane >> 4;
    const int K = g.K, nt = K / BK;
    int ts_lo = 0, ts_hi = 0, nts = 0; const unsigned long long rt_entry = STAMP ? (unsigned long long)wall_clock64() : 0ull;
#define PG8_STAMP() do { if (STAMP && wid == 0 && nts < 64) { const unsigned long long _c = (unsigned long long)clock64(); \
        ts_lo = (lane == nts) ? (int)(unsigned)_c : ts_lo; ts_hi = (lane == nts) ? (int)(unsigned)(_c >> 32) : ts_hi; ++nts; } } while (0)
    PG8_STAMP();
    unsigned voffA[2], voffB[2];
#pragma unroll
    for (int i = 0; i < 2; ++i) { int R, C; stage_rc(tid * 16 + i * 8192, R, C); const int Rb = Epi::PERM ? ((R & ~31) + perm32(R & 31)) : R;
        voffA[i] = (unsigned)(R * K + C) * 2u; voffB[i] = (unsigned)(Rb * K + C) * 2u; }
    const size_t kstep = (size_t)(BK * 2);
    const size_t hstep = (size_t)HALF * K * 2;
    const size_t tstep = 2 * hstep;
    const unsigned ldsw = (unsigned)wid * 1024u;
    const int aoff = lds_byte(wr * 64 + fr, fq * 8), boff = lds_byte(wc * 32 + fr, fq * 8);
#define PG8_SA(b, h) (((b) * 2 + (h)) * HTB)
#define PG8_SB(b, h) ((4 + (b) * 2 + (h)) * HTB)
#define PG8_STAGE(bufoff, gbase, voff) do { _Pragma("unroll") for (int _i = 0; _i < 2; ++_i) \
        __builtin_amdgcn_global_load_lds((const unsigned*)((const char*)(gbase) + (voff)[_i]), (PG8_LAS unsigned*)(lds + (bufoff) + ldsw + _i * 8192), 16, 0, 0); } while (0)
#define PG8_LDA(dst, b, h) do { _Pragma("unroll") for (int m = 0; m < 4; ++m) _Pragma("unroll") for (int k = 0; k < 2; ++k) dst[m][k] = *(const PG8_LAS bf16x8*)(lds + PG8_SA(b, h) + aoff + m * 2048 + k * 1024); } while (0)
#define PG8_LDB(dst, b, h) do { _Pragma("unroll") for (int n = 0; n < 2; ++n) _Pragma("unroll") for (int k = 0; k < 2; ++k) dst[n][k] = *(const PG8_LAS bf16x8*)(lds + PG8_SB(b, h) + boff + n * 2048 + k * 1024); } while (0)
#define PG8_MMA(ai, bj, At, Bt) do { __builtin_amdgcn_s_setprio(1); _Pragma("unroll") for (int m = 0; m < 4; ++m) _Pragma("unroll") for (int n = 0; n < 2; ++n) _Pragma("unroll") for (int k = 0; k < 2; ++k) \
        acc[ai][bj][m][n] = __builtin_amdgcn_mfma_f32_16x16x32_bf16(Bt[n][k], At[m][k], acc[ai][bj][m][n], 0, 0, 0); __builtin_amdgcn_s_setprio(0); } while (0)
#define PG8_WAIT_V(n) asm volatile("s_waitcnt vmcnt(" #n ")" ::: "memory")
#define PG8_WAIT_L(n) asm volatile("s_waitcnt lgkmcnt(" #n ")" ::: "memory")
#define PG8_BAR __builtin_amdgcn_s_barrier()
#define PG8_SCHED __builtin_amdgcn_sched_barrier(0)
    Unit cur, nxt; int ui = 0;
    if (!S.next(0, cur)) return;
    f32x4 acc[2][2][4][2];
#pragma unroll
    for (int a = 0; a < 2; ++a)
#pragma unroll
        for (int b = 0; b < 2; ++b)
#pragma unroll
            for (int m = 0; m < 4; ++m)
#pragma unroll
                for (int n = 0; n < 2; ++n) acc[a][b][m][n] = (f32x4){0.f, 0.f, 0.f, 0.f};
    bf16x8 At[4][2], B0[2][2], B1[2][2];
    const char* cA = (const char*)g.A + (size_t)cur.pm * tstep; const char* cB = (const char*)g.Bt + (size_t)cur.pn * tstep;
    S.a_ready(cur);
    PG8_STAGE(PG8_SB(0, 0), cB, voffB); PG8_STAGE(PG8_SA(0, 0), cA, voffA); PG8_STAGE(PG8_SB(0, 1), cB + hstep, voffB); PG8_STAGE(PG8_SA(0, 1), cA + hstep, voffA);
    if (wr == 1) PG8_BAR;
    PG8_WAIT_V(4); PG8_BAR;
    PG8_STAGE(PG8_SB(1, 0), cB + kstep, voffB); PG8_STAGE(PG8_SA(1, 0), cA + kstep, voffA); PG8_STAGE(PG8_SB(1, 1), cB + hstep + kstep, voffB);
    PG8_WAIT_V(6); PG8_BAR;
    PG8_STAMP();
    for (;;) {
        const bool has_next = S.next(ui + 1, nxt);
        const char* nA = has_next ? (const char*)g.A + (size_t)nxt.pm * tstep : cA; const char* nB = has_next ? (const char*)g.Bt + (size_t)nxt.pn * tstep : cB;
        for (int t = 0; t < nt; t += 2) {
            const bool last = (t == nt - 2);
            const char* a1 = cA + (size_t)(t + 1) * kstep;
            const char* a2 = last ? nA : cA + (size_t)(t + 2) * kstep; const char* b2 = last ? nB : cB + (size_t)(t + 2) * kstep;
            const char* a3 = a2 + kstep; const char* b3 = b2 + kstep;
            if (last && has_next) S.a_ready(nxt);
            PG8_LDB(B0, 0, 0); PG8_SCHED; PG8_LDA(At, 0, 0); PG8_STAGE(PG8_SA(1, 1), a1 + hstep, voffA);
            PG8_WAIT_L(8); PG8_BAR; PG8_WAIT_L(0); PG8_MMA(0, 0, At, B0); PG8_BAR; PG8_SCHED;
            PG8_LDB(B1, 0, 1); PG8_STAGE(PG8_SB(0, 0), b2, voffB);
            PG8_BAR; PG8_WAIT_L(0); PG8_MMA(0, 1, At, B1); PG8_BAR;
            PG8_LDA(At, 0, 1); PG8_STAGE(PG8_SA(0, 0), a2, voffA);
            PG8_BAR; PG8_WAIT_L(0); PG8_MMA(1, 0, At, B0); PG8_BAR; PG8_SCHED;
            PG8_STAGE(PG8_SB(0, 1), b2 + hstep, voffB);
            PG8_WAIT_V(6); PG8_BAR; PG8_MMA(1, 1, At, B1); PG8_BAR;
            PG8_LDB(B0, 1, 0); PG8_SCHED; PG8_LDA(At, 1, 0); PG8_STAGE(PG8_SA(0, 1), a2 + hstep, voffA);
            PG8_WAIT_L(8); PG8_BAR; PG8_WAIT_L(0); PG8_MMA(0, 0, At, B0); PG8_BAR; PG8_SCHED;
            PG8_LDB(B1, 1, 1); PG8_STAGE(PG8_SB(1, 0), b3, voffB);
            PG8_BAR; PG8_WAIT_L(0); PG8_MMA(0, 1, At, B1); PG8_BAR;
            PG8_LDA(At, 1, 1); PG8_STAGE(PG8_SA(1, 0), a3, voffA);
            PG8_BAR; PG8_WAIT_L(0); PG8_MMA(1, 0, At, B0); PG8_BAR; PG8_SCHED;
            PG8_STAGE(PG8_SB(1, 1), b3 + hstep, voffB);
            PG8_WAIT_V(6); PG8_BAR; PG8_MMA(1, 1, At, B1); PG8_BAR;
        }
        PG8_STAMP();
        if constexpr (!Epi::AFTER_DRAIN) { E(acc, cur, wr, wc, fr, fq); S.done(cur); }
        PG8_STAMP();
        if (!has_next) break;
#pragma unroll
        for (int a = 0; a < 2; ++a)
#pragma unroll
            for (int b = 0; b < 2; ++b)
#pragma unroll
                for (int m = 0; m < 4; ++m)
#pragma unroll
                    for (int n = 0; n < 2; ++n) acc[a][b][m][n] = (f32x4){0.f, 0.f, 0.f, 0.f};
        cur = nxt; cA = nA; cB = nB; ++ui;
    }
    PG8_WAIT_V(0);
    if (wr == 0) PG8_BAR;
    PG8_BAR;
    if constexpr (Epi::AFTER_DRAIN) { E.fused(acc, cur, wr, wc, fr, fq, lds, wid, lane); S.done(cur); }
    PG8_STAMP();
    if (STAMP && wid == 0) { stamps[lane] = lane < nts ? (((unsigned long long)(unsigned)ts_hi << 32) | (unsigned)ts_lo) : 0ull;
        if (lane == 62) stamps[62] = rt_entry; if (lane == 63) stamps[63] = (unsigned long long)wall_clock64(); }
#undef PG8_STAMP
#undef PG8_SA
#undef PG8_SB
#undef PG8_STAGE
#undef PG8_LDA
#undef PG8_LDB
#undef PG8_MMA
#undef PG8_WAIT_V
#undef PG8_WAIT_L
#undef PG8_BAR
#undef PG8_SCHED
}
}
typedef unsigned short u16; typedef unsigned int u32;
typedef u32 u32x2 __attribute__((ext_vector_type(2)));
typedef u32 u32x4 __attribute__((ext_vector_type(4)));
typedef float f32x16 __attribute__((ext_vector_type(16)));
typedef __bf16 bf16v2 __attribute__((ext_vector_type(2)));
using pg8::bf16x8; using pg8::f32x4;
#define DI __device__ __forceinline__
DI u32 pk2(float a, float b) { bf16v2 v = {(__bf16)a, (__bf16)b}; return __builtin_bit_cast(u32, v); }
DI float bf_lo(u32 w) { return __uint_as_float(w << 16); }
DI float bf_hi(u32 w) { return __uint_as_float(w & 0xffff0000u); }
DI float bf2f(u16 h) { return __uint_as_float((u32)h << 16); }
DI float fast_sigmoid(float x) { return __builtin_amdgcn_rcpf(1.0f + __builtin_amdgcn_exp2f(-1.44269504089f * x)); }
DI float gelu_tanh(float x) { const float z = 0.7978845608f * (x + 0.044715f * x * x * x); return x * fast_sigmoid(2.0f * z); }
DI float silu_f(float x) { return x * fast_sigmoid(x); }

constexpr int NB = 16, SEQ = 2048, DM = 2048, NTOK = NB * SEQ;
constexpr int NP = 8960;
constexpr int C_U = 0, C_VA = 1024, C_Q = 2048, C_QI = 3072, C_GA = 4096, C_GB = 6144, C_K = 8192, C_VB = 8448, C_KI = 8704, C_WI = 8768;
constexpr int DFF = 5632, NUP = 11264, NMOD = 12288, KSPL = 32;
constexpr int HALF_TOK = NTOK / 2;
constexpr float EPSN = 1e-6f;
constexpr int LDS_BYTES = 131072;
constexpr int NPH = 14;

constexpr size_t WS_WT_IN = 0;
constexpr size_t WS_WT_A = WS_WT_IN + (size_t)NP * 2048 * 2;
constexpr size_t WS_WT_B = WS_WT_A + (size_t)2048 * 1024 * 2;
constexpr size_t WS_WT_OUT = WS_WT_B + (size_t)2048 * 1024 * 2;
constexpr size_t WS_WT_UP = WS_WT_OUT + (size_t)2048 * 2048 * 2;
constexpr size_t WS_WT_DN = WS_WT_UP + (size_t)NUP * 2048 * 2;
constexpr size_t WS_MODP = WS_WT_DN + (size_t)2048 * DFF * 2;
constexpr size_t WS_MOD = WS_MODP + (size_t)KSPL * NB * NMOD * 4;
constexpr size_t WS_MASK = WS_MOD + (size_t)NB * NMOD * 4;
constexpr size_t WS_KN = WS_MASK + (size_t)NTOK * 64 * 4;
constexpr size_t WS_VT = WS_KN + (size_t)NTOK * 256 * 2;
constexpr size_t WS_HBUF = WS_VT + (size_t)NTOK * 256 * 2;
constexpr size_t WS_MERGED = WS_HBUF + (size_t)NTOK * 2048 * 2;
constexpr size_t WS_PROJ = WS_MERGED + (size_t)NTOK * 2048 * 2;
constexpr size_t WS_UPRAW = WS_PROJ;
constexpr size_t WS_ACT = WS_PROJ + (size_t)HALF_TOK * NUP * 2;
constexpr size_t WS_END = WS_PROJ + (size_t)NTOK * NP * 2;
static_assert(WS_ACT + (size_t)HALF_TOK * DFF * 2 <= WS_END, "ws alias");

struct Args {
    const float *x, *c, *w_ada, *b_ada, *norm1_g, *w_in, *v_norm_g, *w_spatial, *b_spatial, *q_norm_g, *k_norm_g, *w_proj_a, *w_proj_b, *w_out, *norm2_g, *w_up, *conv_w, *conv_b, *w_down;
    float* out; unsigned char* ws; int ph_lo, ph_hi, coop, pad;
};
struct WS {
    u16 *wt_in, *wt_a, *wt_b, *wt_out, *wt_up, *wt_dn; float *modp, *mod; u32* mask; u16 *kn, *vt, *hbuf, *ya, *yb, *merged, *proj, *upraw, *act;
};
DI WS make_ws(unsigned char* p) {
    WS w; w.wt_in = (u16*)(p + WS_WT_IN); w.wt_a = (u16*)(p + WS_WT_A); w.wt_b = (u16*)(p + WS_WT_B); w.wt_out = (u16*)(p + WS_WT_OUT); w.wt_up = (u16*)(p + WS_WT_UP); w.wt_dn = (u16*)(p + WS_WT_DN);
    w.modp = (float*)(p + WS_MODP); w.mod = (float*)(p + WS_MOD); w.mask = (u32*)(p + WS_MASK); w.kn = (u16*)(p + WS_KN); w.vt = (u16*)(p + WS_VT); w.hbuf = (u16*)(p + WS_HBUF);
    w.ya = w.hbuf; w.yb = w.hbuf + (size_t)NTOK * 1024; w.merged = (u16*)(p + WS_MERGED); w.proj = (u16*)(p + WS_PROJ); w.upraw = (u16*)(p + WS_UPRAW); w.act = (u16*)(p + WS_ACT);
    return w;
}

DI int map_in(int n) {
    if (n < 3072) return n;
    if (n < 3328) return n - 3072 + C_K;
    if (n < 3584) return n - 3328 + C_VB;
    if (n < 4608) return n - 3584 + C_QI;
    if (n < 4672) return n - 4608 + C_KI;
    if (n < 4688) return n - 4672 + C_WI;
    if (n < 6736) return n - 4688 + C_GA;
    return n - 6736 + C_GB;
}
DI void conv_tile(const float* __restrict__ src, u16* __restrict__ dst, int K, int N, int kt, int nt, int mode, float* tile) {
    const int tid = threadIdx.x, tx = tid & 63, ty = tid >> 6;
    const int n = nt * 64 + tx;
#pragma unroll
    for (int i = 0; i < 8; ++i) { const int kl = ty * 8 + i; tile[kl * 65 + tx] = (n < N) ? src[(size_t)(kt * 64 + kl) * N + n] : 0.f; }
    __syncthreads();
    const int nl = tid >> 3, kc = tid & 7, n2 = nt * 64 + nl;
    if (n2 < N) {
        const int dn = mode ? map_in(n2) : n2;
        u32x4 o;
#pragma unroll
        for (int e = 0; e < 4; ++e) o[e] = pk2(tile[(kc * 8 + 2 * e) * 65 + nl], tile[(kc * 8 + 2 * e + 1) * 65 + nl]);
        *(u32x4*)(dst + (size_t)dn * K + kt * 64 + kc * 8) = o;
    }
    __syncthreads();
}
DI void phase0(const Args& a, const WS& w, unsigned char* lds) {
    float* tile = (float*)lds;
    const float* srcs[6] = {a.w_in, a.w_proj_a, a.w_proj_b, a.w_out, a.w_up, a.w_down};
    u16* dsts[6] = {w.wt_in, w.wt_a, w.wt_b, w.wt_out, w.wt_up, w.wt_dn};
    const int Ks[6] = {2048, 1024, 1024, 2048, 2048, DFF}, Ns[6] = {8784, 2048, 2048, 2048, NUP, 2048};
    int base = 0;
#pragma unroll
    for (int i = 0; i < 6; ++i) {
        const int nkt = Ks[i] / 64, nnt = (Ns[i] + 63) / 64, cnt = nkt * nnt;
        int first = (int)blockIdx.x - (base % (int)gridDim.x); if (first < 0) first += gridDim.x;
        for (int t = first; t < cnt; t += gridDim.x) conv_tile(srcs[i], dsts[i], Ks[i], Ns[i], t % nkt, t / nkt, i == 0, tile);
        base += cnt;
    }
    { u32x4 z = {0u, 0u, 0u, 0u}; u32x4* p = (u32x4*)(w.wt_in + (size_t)8784 * 2048); const int n16 = (NP - 8784) * 2048 / 8;
      for (int i = blockIdx.x * 512 + threadIdx.x; i < n16; i += gridDim.x * 512) p[i] = z; }
    float* sl = (float*)lds;
    for (int item = blockIdx.x; item < KSPL * 24; item += gridDim.x) {
        const int ks = item / 24, nc = item % 24;
        __syncthreads();
        for (int e = threadIdx.x; e < 1024; e += 512) { const int k = e >> 4, b = e & 15; const float cv = a.c[b * 2048 + ks * 64 + k]; sl[e] = silu_f(cv); }
        __syncthreads();
        const int n = nc * 512 + threadIdx.x;
        float acc[16];
#pragma unroll
        for (int b = 0; b < 16; ++b) acc[b] = 0.f;
        const float* wp = a.w_ada + (size_t)(ks * 64) * NMOD + n;
#pragma unroll 4
        for (int k = 0; k < 64; ++k) {
            const float wv = wp[(size_t)k * NMOD];
            const f32x4* s4 = (const f32x4*)(sl + k * 16);
#pragma unroll
            for (int q = 0; q < 4; ++q) { const f32x4 s = s4[q]; acc[4 * q] += s[0] * wv; acc[4 * q + 1] += s[1] * wv; acc[4 * q + 2] += s[2] * wv; acc[4 * q + 3] += s[3] * wv; }
        }
#pragma unroll
        for (int b = 0; b < 16; ++b) w.modp[((size_t)ks * 16 + b) * NMOD + n] = acc[b];
    }
    __syncthreads();
}

DI void rms_phase(const Args& a, const WS& w, unsigned char* lds, const float* __restrict__ xin, const float* __restrict__ g, int sh_off, int sc_off, u16* __restrict__ hout, bool finalize) {
    float* gs = (float*)lds; float* shs = gs + 2048;
    const int lane = threadIdx.x & 63, wave = threadIdx.x >> 6;
    if (finalize) {
        for (int e = blockIdx.x * 512 + threadIdx.x; e < NB * NMOD; e += gridDim.x * 512) {
            const int b = e / NMOD, n = e % NMOD; float s = a.b_ada[n];
            for (int ks = 0; ks < KSPL; ++ks) s += w.modp[((size_t)ks * 16 + b) * NMOD + n];
            w.mod[e] = s;
        }
    }
    for (int rb = blockIdx.x; rb < NTOK / 128; rb += gridDim.x) {
        const int b = rb / 16;
        __syncthreads();
        for (int c = threadIdx.x; c < 2048; c += 512) {
            float sc = a.b_ada[sc_off + c], sh = a.b_ada[sh_off + c];
            for (int ks = 0; ks < KSPL; ++ks) { const float* mp = w.modp + ((size_t)ks * 16 + b) * NMOD; sc += mp[sc_off + c]; sh += mp[sh_off + c]; }
            gs[c] = g[c] * (1.0f + sc); shs[c] = sh;
        }
        __syncthreads();
        for (int r = 0; r < 16; ++r) {
            const size_t row = (size_t)rb * 128 + wave * 16 + r;
            const f32x4* xp = (const f32x4*)(xin + row * 2048);
            f32x4 v[8]; float ss = 0.f;
#pragma unroll
            for (int i = 0; i < 8; ++i) { v[i] = xp[i * 64 + lane]; ss += v[i][0] * v[i][0] + v[i][1] * v[i][1] + v[i][2] * v[i][2] + v[i][3] * v[i][3]; }
#pragma unroll
            for (int o = 32; o >= 1; o >>= 1) ss += __shfl_xor(ss, o);
            const float rstd = rsqrtf(ss * (1.0f / 2048.0f) + EPSN);
#pragma unroll
            for (int i = 0; i < 8; ++i) {
                const int col = (i * 64 + lane) * 4; const f32x4 gg = *(const f32x4*)(gs + col), hh = *(const f32x4*)(shs + col);
                u32x2 o; o[0] = pk2(v[i][0] * rstd * gg[0] + hh[0], v[i][1] * rstd * gg[1] + hh[1]); o[1] = pk2(v[i][2] * rstd * gg[2] + hh[2], v[i][3] * rstd * gg[3] + hh[3]);
                *(u32x2*)(hout + row * 2048 + col) = o;
            }
        }
    }
    __syncthreads();
}
using pg8::Unit; using pg8::BM; using pg8::HALF;
struct EpiProj {
    static constexpr bool PERM = true, AFTER_DRAIN = false;
    u16* O;
    __device__ __forceinline__ void operator()(const f32x4 (&acc)[2][2][4][2], const Unit& u, int wr, int wc, int fr, int fq) const {
        const int row0 = u.pm * BM + wr * 64 + fr, col0 = u.pn * BM + wc * 32 + 8 * fq;
        const int mode = (u.pn < 8) ? 1 : ((u.pn >= 16 && u.pn < 32) ? 2 : 0);
#pragma unroll
        for (int ai = 0; ai < 2; ++ai)
#pragma unroll
            for (int m = 0; m < 4; ++m) { u16* rowp = O + (size_t)(row0 + ai * HALF + m * 16) * NP + col0;
#pragma unroll
                for (int bj = 0; bj < 2; ++bj) { float v[8];
#pragma unroll
                    for (int e = 0; e < 4; ++e) { v[e] = acc[ai][bj][m][0][e]; v[4 + e] = acc[ai][bj][m][1][e]; }
                    if (mode == 1) {
#pragma unroll
                        for (int e = 0; e < 8; ++e) v[e] = gelu_tanh(v[e]);
                    } else if (mode == 2) {
#pragma unroll
                        for (int e = 0; e < 8; ++e) v[e] = fast_sigmoid(v[e]);
                    }
                    u32x4 o; o[0] = pk2(v[0], v[1]); o[1] = pk2(v[2], v[3]); o[2] = pk2(v[4], v[5]); o[3] = pk2(v[6], v[7]);
                    *(u32x4*)(rowp + bj * HALF) = o; } }
    }
};
struct EpiGate {
    static constexpr bool PERM = true, AFTER_DRAIN = false;
    u16* T; const u16* proj; int gcol; int first;
    __device__ __forceinline__ void operator()(const f32x4 (&acc)[2][2][4][2], const Unit& u, int wr, int wc, int fr, int fq) const {
        const int row0 = u.pm * BM + wr * 64 + fr, col0 = u.pn * BM + wc * 32 + 8 * fq;
#pragma unroll
        for (int ai = 0; ai < 2; ++ai)
#pragma unroll
            for (int m = 0; m < 4; ++m) { const size_t row = (size_t)(row0 + ai * HALF + m * 16);
#pragma unroll
                for (int bj = 0; bj < 2; ++bj) { const int col = col0 + bj * HALF;
                    const u32x4 gw = *(const u32x4*)(proj + row * NP + gcol + col);
                    float v[8];
#pragma unroll
                    for (int e = 0; e < 4; ++e) { v[e] = acc[ai][bj][m][0][e]; v[4 + e] = acc[ai][bj][m][1][e]; }
#pragma unroll
                    for (int e = 0; e < 4; ++e) { v[2 * e] *= bf_lo(gw[e]); v[2 * e + 1] *= bf_hi(gw[e]); }
                    u16* tp = T + row * 2048 + col;
                    if (!first) { const u32x4 tw = *(const u32x4*)tp;
#pragma unroll
                        for (int e = 0; e < 4; ++e) { v[2 * e] += bf_lo(tw[e]); v[2 * e + 1] += bf_hi(tw[e]); } }
                    u32x4 o; o[0] = pk2(v[0], v[1]); o[1] = pk2(v[2], v[3]); o[2] = pk2(v[4], v[5]); o[3] = pk2(v[6], v[7]);
                    *(u32x4*)tp = o; } }
    }
};
struct EpiRes {
    static constexpr bool PERM = false, AFTER_DRAIN = false;
    float* O; const float* R; const float* mod; int goff; int row_off;
    __device__ __forceinline__ void operator()(const f32x4 (&acc)[2][2][4][2], const Unit& u, int wr, int wc, int fr, int fq) const {
        const int row0 = row_off + u.pm * BM + wr * 64 + fr, col0 = u.pn * BM + wc * 32 + 4 * fq;
        const int b = (row_off + u.pm * BM) / SEQ;
        f32x4 gv[2][2];
#pragma unroll
        for (int bj = 0; bj < 2; ++bj)
#pragma unroll
            for (int n = 0; n < 2; ++n) gv[bj][n] = *(const f32x4*)(mod + (size_t)b * NMOD + goff + col0 + bj * HALF + n * 16);
#pragma unroll
        for (int ai = 0; ai < 2; ++ai)
#pragma unroll
            for (int m = 0; m < 4; ++m) { const size_t ro = (size_t)(row0 + ai * HALF + m * 16) * 2048 + col0;
#pragma unroll
                for (int bj = 0; bj < 2; ++bj)
#pragma unroll
                    for (int n = 0; n < 2; ++n) { const f32x4 r = *(const f32x4*)(R + ro + bj * HALF + n * 16);
                        *(f32x4*)(O + ro + bj * HALF + n * 16) = r + gv[bj][n] * acc[ai][bj][m][n]; } }
    }
};
struct EpiRaw {
    static constexpr bool PERM = true, AFTER_DRAIN = false;
    u16* O; int ldc;
    __device__ __forceinline__ void operator()(const f32x4 (&acc)[2][2][4][2], const Unit& u, int wr, int wc, int fr, int fq) const {
        const int row0 = u.pm * BM + wr * 64 + fr, col0 = u.pn * BM + wc * 32 + 8 * fq;
#pragma unroll
        for (int ai = 0; ai < 2; ++ai)
#pragma unroll
            for (int m = 0; m < 4; ++m) { u16* rowp = O + (size_t)(row0 + ai * HALF + m * 16) * ldc + col0;
#pragma unroll
                for (int bj = 0; bj < 2; ++bj) { const f32x4 v0 = acc[ai][bj][m][0], v1 = acc[ai][bj][m][1];
                    u32x4 o; o[0] = pk2(v0[0], v0[1]); o[1] = pk2(v0[2], v0[3]); o[2] = pk2(v1[0], v1[1]); o[3] = pk2(v1[2], v1[3]);
                    *(u32x4*)(rowp + bj * HALF) = o; } }
    }
};
template <class Epi> DI void run_gemm(unsigned char* lds, const u16* A, const u16* Bt, int M, int N, int K, const Epi& E) {
    pg8::Gemm g; g.A = A; g.Bt = Bt; g.M = M; g.N = N; g.K = K;
    pg8::StaticOrder S; S.init(M, N, (int)gridDim.x, (int)blockIdx.x);
    pg8::gemm_phase<Epi, pg8::StaticOrder, false>((PG8_LAS unsigned char*)lds, g, S, E, nullptr);
    __syncthreads();
}

DI void mixer_a_phase(const Args& a, const WS& w, unsigned char* lds) {
    const int lane = threadIdx.x & 63, wave = threadIdx.x >> 6, fr = lane & 15, fq = lane >> 4;
    float* rstd_s = (float*)lds;
    u16* VT = (u16*)(lds + 1024) + wave * (32 * 136);
    for (int item = blockIdx.x; item < 256; item += gridDim.x) {
        const int t0 = item * 128;
        __syncthreads();
        for (int r = 0; r < 16; ++r) {
            const u16* rp = w.proj + (size_t)(t0 + wave * 16 + r) * NP + C_VA;
            const u32x4 x0 = *(const u32x4*)(rp + lane * 8), x1 = *(const u32x4*)(rp + 512 + lane * 8);
            float ss = 0.f;
#pragma unroll
            for (int e = 0; e < 4; ++e) { float p = bf_lo(x0[e]), q = bf_hi(x0[e]), r2 = bf_lo(x1[e]), s2 = bf_hi(x1[e]); ss += p * p + q * q + r2 * r2 + s2 * s2; }
#pragma unroll
            for (int o = 32; o >= 1; o >>= 1) ss += __shfl_xor(ss, o);
            if (lane == 0) rstd_s[wave * 16 + r] = rsqrtf(ss * (1.0f / 1024.0f) + EPSN);
        }
        __syncthreads();
        const int g = wave;
        for (int ch = 0; ch < 4; ++ch) {
            const int cbase = g * 128 + ch * 32;
            const int cl = lane & 31, sp = lane >> 5;
            const float vg = a.v_norm_g[cbase + cl];
            __syncthreads();
#pragma unroll 4
            for (int s2 = 0; s2 < 64; ++s2) {
                const int s = 2 * s2 + sp;
                const float v = bf2f(w.proj[(size_t)(t0 + s) * NP + C_VA + cbase + cl]) * rstd_s[s] * vg;
                VT[cl * 136 + s] = (u16)(pk2(v, 0.f) & 0xffffu);
            }
            __syncthreads();
#pragma unroll 1
            for (int tt = 0; tt < 8; ++tt) {
                f32x4 acc0 = (f32x4){0.f, 0.f, 0.f, 0.f}, acc1 = acc0;
                const int t = tt * 16 + fr;
                const float* wrow = a.w_spatial + ((size_t)g * 128 + t) * 128;
#pragma unroll 1
                for (int sc = 0; sc <= (tt >> 1); ++sc) {
                    const int sb = sc * 32 + 8 * fq;
                    const f32x4 a0 = *(const f32x4*)(wrow + sb), a1 = *(const f32x4*)(wrow + sb + 4);
                    float av[8];
#pragma unroll
                    for (int e = 0; e < 4; ++e) { av[e] = (sb + e <= t) ? a0[e] : 0.f; av[4 + e] = (sb + 4 + e <= t) ? a1[e] : 0.f; }
                    u32x4 ap; ap[0] = pk2(av[0], av[1]); ap[1] = pk2(av[2], av[3]); ap[2] = pk2(av[4], av[5]); ap[3] = pk2(av[6], av[7]);
                    const bf16x8 Af = __builtin_bit_cast(bf16x8, ap);
                    const bf16x8 B0 = *(const bf16x8*)(VT + fr * 136 + sb), B1 = *(const bf16x8*)(VT + (16 + fr) * 136 + sb);
                    acc0 = __builtin_amdgcn_mfma_f32_16x16x32_bf16(Af, B0, acc0, 0, 0, 0);
                    acc1 = __builtin_amdgcn_mfma_f32_16x16x32_bf16(Af, B1, acc1, 0, 0, 0);
                }
#pragma unroll
                for (int i = 0; i < 4; ++i) {
                    const int to = tt * 16 + 4 * fq + i; const float bs = a.b_spatial[g * 128 + to];
                    const size_t tok = (size_t)(t0 + to);
                    const int c = cbase + fr;
                    const float u0 = bf2f(w.proj[tok * NP + C_U + c]), u1 = bf2f(w.proj[tok * NP + C_U + c + 16]);
                    w.ya[tok * 1024 + c] = (u16)(pk2(u0 * (acc0[i] + bs), 0.f) & 0xffffu);
                    w.ya[tok * 1024 + c + 16] = (u16)(pk2(u1 * (acc1[i] + bs), 0.f) & 0xffffu);
                }
            }
        }
    }
    __syncthreads();
}

DI void kv_prep_phase(const Args& a, const WS& w, unsigned char* lds) {
    const int lane = threadIdx.x & 63, wave = threadIdx.x >> 6;
    const int gw = blockIdx.x * 8 + wave, nw = gridDim.x * 8;
    const f32x4 kg = *(const f32x4*)(a.k_norm_g + (lane & 31) * 4);
    for (int t = gw; t < NTOK; t += nw) {
        const u32x2 kv = *(const u32x2*)(w.proj + (size_t)t * NP + C_K + lane * 4);
        const float v0 = bf_lo(kv[0]), v1 = bf_hi(kv[0]), v2 = bf_lo(kv[1]), v3 = bf_hi(kv[1]);
        float ss = v0 * v0 + v1 * v1 + v2 * v2 + v3 * v3;
#pragma unroll
        for (int o = 16; o >= 1; o >>= 1) ss += __shfl_xor(ss, o);
        const float rstd = rsqrtf(ss * (1.0f / 128.0f) + EPSN);
        u32x2 o; o[0] = pk2(v0 * rstd * kg[0], v1 * rstd * kg[1]); o[1] = pk2(v2 * rstd * kg[2], v3 * rstd * kg[3]);
        *(u32x2*)(w.kn + (size_t)t * 256 + lane * 4) = o;
    }
    u16* tile = (u16*)lds;
    const int tid = threadIdx.x;
    for (int item = blockIdx.x; item < NB * 32 * 4; item += gridDim.x) {
        const int b = item >> 7, st = (item >> 2) & 31, dt = item & 3;
        __syncthreads();
        { const int sr = tid >> 3, dc = (tid & 7) * 8;
          *(u32x4*)(tile + sr * 72 + dc) = *(const u32x4*)(w.proj + (size_t)(b * SEQ + st * 64 + sr) * NP + C_VB + dt * 64 + dc); }
        __syncthreads();
        { const int dr = tid >> 3, sc8 = (tid & 7) * 8; u32x4 o;
#pragma unroll
          for (int e = 0; e < 4; ++e) o[e] = (u32)tile[(sc8 + 2 * e) * 72 + dr] | ((u32)tile[(sc8 + 2 * e + 1) * 72 + dr] << 16);
          *(u32x4*)(w.vt + ((size_t)b * 256 + dt * 64 + dr) * SEQ + st * 64 + sc8) = o; }
    }
    __syncthreads();
}
#define MFMA32(a, b, c) __builtin_amdgcn_mfma_f32_32x32x16_bf16((a), (b), (c), 0, 0, 0)
DI void indexer_phase(const Args& a, const WS& w, unsigned char* lds) {
    const int lane = threadIdx.x & 63, wave = threadIdx.x >> 6, hb = lane >> 5, l32 = lane & 31;
    const int gw = blockIdx.x * 8 + wave, nw = gridDim.x * 8;
    float* scl = (float*)(lds + wave * 16384);
    const float idx_scale = 0.125f * 0.25f;
    int r = 0;
    for (int pair0 = gw; pair0 < NTOK / 2; pair0 += nw, ++r) {
        const int b = pair0 >> 10; int pi = pair0 & 1023; if (r & 1) pi = 1023 - pi;
        const int p0 = 2 * pi, t0 = b * SEQ + p0;
        bf16x8 Af[4];
        { const u16* qp = w.proj + (size_t)(t0 + (l32 >> 4)) * NP + C_QI + (l32 & 15) * 64 + 8 * hb;
#pragma unroll
          for (int kk = 0; kk < 4; ++kk) Af[kk] = *(const bf16x8*)(qp + 16 * kk); }
        float wv0[8], wv1[8];
#pragma unroll
        for (int i = 0; i < 8; ++i) { const int h = 8 * (i >> 2) + 4 * hb + (i & 3);
            wv0[i] = bf2f(w.proj[(size_t)t0 * NP + C_WI + h]) * idx_scale; wv1[i] = bf2f(w.proj[(size_t)(t0 + 1) * NP + C_WI + h]) * idx_scale; }
        const int jmax = (p0 + 1) >> 5;
        const u16* kp = w.proj + (size_t)(b * SEQ + l32) * NP + C_KI + 8 * hb;
        bf16x8 Bn[4];
#pragma unroll
        for (int kk = 0; kk < 4; ++kk) Bn[kk] = *(const bf16x8*)(kp + 16 * kk);
        for (int j = 0; j <= jmax; ++j) {
            bf16x8 Bc[4];
#pragma unroll
            for (int kk = 0; kk < 4; ++kk) Bc[kk] = Bn[kk];
            if (j < jmax) { const u16* kq = kp + (size_t)(j + 1) * 32 * NP;
#pragma unroll
                for (int kk = 0; kk < 4; ++kk) Bn[kk] = *(const bf16x8*)(kq + 16 * kk); }
            f32x16 cacc;
#pragma unroll
            for (int i = 0; i < 16; ++i) cacc[i] = 0.f;
#pragma unroll
            for (int kk = 0; kk < 4; ++kk) cacc = MFMA32(Af[kk], Bc[kk], cacc);
            float s0 = 0.f, s1 = 0.f;
#pragma unroll
            for (int i = 0; i < 8; ++i) { s0 += wv0[i] * fmaxf(cacc[i], 0.f); s1 += wv1[i] * fmaxf(cacc[8 + i], 0.f); }
            float mine = hb ? s1 : s0; const float oth = hb ? s0 : s1;
            mine += __shfl_xor(oth, 32);
            scl[hb * 2048 + j * 32 + l32] = mine;
        }
        asm volatile("s_waitcnt lgkmcnt(0)" ::: "memory");
        const int pl = p0 + hb;
        u32 uk[64];
#pragma unroll
        for (int j = 0; j < 64; ++j) {
            const int key = j * 32 + l32;
            const bool valid = key <= pl;
            const u32 u = __float_as_uint(scl[hb * 2048 + (valid ? key : 0)]);
            const u32 s = (u & 0x80000000u) ? ~u : (u | 0x80000000u);
            uk[j] = valid ? s : 0u;
        }
        asm volatile("s_waitcnt lgkmcnt(0)" ::: "memory");
        u32 T0 = 0u, T1 = 0u; bool done0 = (p0 + 1 <= 256), done1 = (p0 + 2 <= 256);
        if (done0) T0 = 1u; if (done1) T1 = 1u;
        for (int bit = 31; bit >= 0; --bit) {
            if (done0 && done1) break;
            const u32 c0 = T0 | (1u << bit), c1 = T1 | (1u << bit);
            const u32 cv = hb ? c1 : c0;
            int cnt = 0;
#pragma unroll
            for (int j = 0; j < 64; ++j) cnt += (uk[j] >= cv) ? 1 : 0;
#pragma unroll
            for (int o = 16; o >= 1; o >>= 1) cnt += __shfl_xor(cnt, o);
            const int n0 = __builtin_amdgcn_readlane(cnt, 0), n1 = __builtin_amdgcn_readlane(cnt, 32);
            if (!done0) { if (n0 >= 256) T0 = c0; if (n0 == 256) done0 = true; }
            if (!done1) { if (n1 >= 256) T1 = c1; if (n1 == 256) done1 = true; }
        }
        const u32 Tv = hb ? T1 : T0;
        int gcnt = 0;
#pragma unroll
        for (int j = 0; j < 64; ++j) gcnt += (uk[j] > Tv) ? 1 : 0;
#pragma unroll
        for (int o = 16; o >= 1; o >>= 1) gcnt += __shfl_xor(gcnt, o);
        const int g0 = __builtin_amdgcn_readlane(gcnt, 0), g1 = __builtin_amdgcn_readlane(gcnt, 32);
        const int need0 = done0 ? 0x7fffffff : 256 - g0, need1 = done1 ? 0x7fffffff : 256 - g1;
        const int need = hb ? need1 : need0;
        int run0 = 0, run1 = 0; u32 w0 = 0u, w1 = 0u;
        const u32 ltmask = (1u << l32) - 1u;
#pragma unroll
        for (int j = 0; j < 64; ++j) {
            const bool eq = (uk[j] == Tv);
            const unsigned long long be = __ballot(eq);
            const u32 mybe = hb ? (u32)(be >> 32) : (u32)be;
            const int rank = (hb ? run1 : run0) + __popc(mybe & ltmask);
            const bool sel = (uk[j] > Tv) || (eq && rank < need);
            run0 += __popc((u32)be); run1 += __popc((u32)(be >> 32));
            const unsigned long long bs = __ballot(sel);
            w0 = (lane == j) ? (u32)bs : w0; w1 = (lane == j) ? (u32)(bs >> 32) : w1;
        }
        w.mask[(size_t)t0 * 64 + lane] = w0; w.mask[(size_t)(t0 + 1) * 64 + lane] = w1;
    }
    __syncthreads();
}

DI void attn_task(const Args& a, const WS& w, int b, int h, int qt) {
    const int lane = threadIdx.x & 63, hb = lane >> 5, l32 = lane & 31;
    const int g = h >> 2, q0 = qt * 32;
    const size_t tq = (size_t)b * SEQ + q0 + l32;
    bf16x8 qf[8];
    { const u16* qp = w.proj + tq * NP + C_Q + h * 128 + 8 * hb;
      u32x4 raw[8]; float ss = 0.f;
#pragma unroll
      for (int kk = 0; kk < 8; ++kk) { raw[kk] = *(const u32x4*)(qp + 16 * kk);
#pragma unroll
          for (int e = 0; e < 4; ++e) { const float lo = bf_lo(raw[kk][e]), hi = bf_hi(raw[kk][e]); ss += lo * lo + hi * hi; } }
      ss += __shfl_xor(ss, 32);
      const float sc = rsqrtf(ss * (1.0f / 128.0f) + EPSN) * 0.08838834764831845f * 1.44269504089f;
#pragma unroll
      for (int kk = 0; kk < 8; ++kk) { const f32x4 g0 = *(const f32x4*)(a.q_norm_g + 16 * kk + 8 * hb), g1 = *(const f32x4*)(a.q_norm_g + 16 * kk + 8 * hb + 4);
          u32x4 o;
          o[0] = pk2(bf_lo(raw[kk][0]) * sc * g0[0], bf_hi(raw[kk][0]) * sc * g0[1]); o[1] = pk2(bf_lo(raw[kk][1]) * sc * g0[2], bf_hi(raw[kk][1]) * sc * g0[3]);
          o[2] = pk2(bf_lo(raw[kk][2]) * sc * g1[0], bf_hi(raw[kk][2]) * sc * g1[1]); o[3] = pk2(bf_lo(raw[kk][3]) * sc * g1[2], bf_hi(raw[kk][3]) * sc * g1[3]);
          qf[kk] = __builtin_bit_cast(bf16x8, o); } }
    f32x16 o[4];
#pragma unroll
    for (int d = 0; d < 4; ++d)
#pragma unroll
        for (int i = 0; i < 16; ++i) o[d][i] = 0.f;
    float m = -INFINITY, lsum = 0.f;
    const int rperm = (l32 & 0x13) | ((l32 & 4) << 1) | ((l32 & 8) >> 1);
    const u16* kbase = w.kn + ((size_t)b * SEQ + rperm) * 256 + g * 128 + 8 * hb;
    const u16* vbase = w.vt + ((size_t)b * 256 + g * 128 + l32) * SEQ + 8 * hb;
    const u32* mp = w.mask + tq * 64;
    for (int kt = 0; kt <= qt; ++kt) {
        const int key0 = kt * 32;
        bf16x8 kf[8];
#pragma unroll
        for (int kk = 0; kk < 8; ++kk) kf[kk] = *(const bf16x8*)(kbase + (size_t)key0 * 256 + 16 * kk);
        const u32 mw = mp[kt] >> (8 * hb);
        bf16x8 vf[4][2];
#pragma unroll
        for (int d = 0; d < 4; ++d)
#pragma unroll
            for (int k2 = 0; k2 < 2; ++k2) vf[d][k2] = *(const bf16x8*)(vbase + (size_t)d * 32 * SEQ + key0 + 16 * k2);
        f32x16 s;
#pragma unroll
        for (int i = 0; i < 16; ++i) s[i] = 0.f;
#pragma unroll
        for (int kk = 0; kk < 8; ++kk) s = MFMA32(kf[kk], qf[kk], s);
        float mx = -INFINITY;
#pragma unroll
        for (int i = 0; i < 16; ++i) { const int bit = 16 * (i >> 3) + (i & 7); s[i] = ((mw >> bit) & 1u) ? s[i] : -INFINITY; mx = fmaxf(mx, s[i]); }
        mx = fmaxf(mx, __shfl_xor(mx, 32));
        const float mnew = fmaxf(m, mx), msafe = (mnew == -INFINITY) ? 0.f : mnew;
        const float alpha = __builtin_amdgcn_exp2f(m - msafe);
        float ps = 0.f;
#pragma unroll
        for (int i = 0; i < 16; ++i) { s[i] = __builtin_amdgcn_exp2f(s[i] - msafe); ps += s[i]; }
        lsum = lsum * alpha + ps; m = mnew;
#pragma unroll
        for (int d = 0; d < 4; ++d)
#pragma unroll
            for (int i = 0; i < 16; ++i) o[d][i] *= alpha;
        bf16x8 pf[2];
#pragma unroll
        for (int k2 = 0; k2 < 2; ++k2) { u32x4 pp;
#pragma unroll
            for (int e = 0; e < 4; ++e) pp[e] = pk2(s[8 * k2 + 2 * e], s[8 * k2 + 2 * e + 1]);
            pf[k2] = __builtin_bit_cast(bf16x8, pp); }
#pragma unroll
        for (int d = 0; d < 4; ++d)
#pragma unroll
            for (int k2 = 0; k2 < 2; ++k2) o[d] = MFMA32(vf[d][k2], pf[k2], o[d]);
    }
    lsum += __shfl_xor(lsum, 32);
    const float inv = 1.0f / lsum;
    u16* op = w.yb + tq * 1024 + h * 128 + 4 * hb;
#pragma unroll
    for (int d = 0; d < 4; ++d)
#pragma unroll
        for (int i4 = 0; i4 < 4; ++i4) { u32x2 ov; ov[0] = pk2(o[d][4 * i4] * inv, o[d][4 * i4 + 1] * inv); ov[1] = pk2(o[d][4 * i4 + 2] * inv, o[d][4 * i4 + 3] * inv);
            *(u32x2*)(op + 32 * d + 8 * i4) = ov; }
}
DI void attn_phase(const Args& a, const WS& w) {
    const int wave = threadIdx.x >> 6;
    if (gridDim.x == 256) {
        const int xcd = blockIdx.x & 7, wx = (blockIdx.x >> 3) * 8 + wave, bhl = wx & 15, x = wx >> 4;
        for (int r = 0; r < 4; ++r) { const int qt = (r & 1) ? (63 - 16 * r - (15 - x)) : (63 - 16 * r - x); attn_task(a, w, 2 * xcd + (bhl >> 3), bhl & 7, qt); }
    } else {
        const int gw = blockIdx.x * 8 + wave, nw = gridDim.x * 8;
        for (int t = gw; t < NB * 8 * 64; t += nw) attn_task(a, w, (t & 127) >> 3, t & 7, 63 - (t >> 7));
    }
}

DI void convact_phase(const Args& a, const WS& w) {
    const int nth = gridDim.x * 512;
    for (int task = blockIdx.x * 512 + threadIdx.x; task < (HALF_TOK / 32) * (DFF / 8); task += nth) {
        const int rb = task / (DFF / 8), ch = task % (DFF / 8), n0 = ch * 8, r0 = rb * 32;
        float wa[3][8], wb[3][8], ca[8], cb[8];
#pragma unroll
        for (int j = 0; j < 3; ++j)
#pragma unroll
            for (int e = 0; e < 8; ++e) { wa[j][e] = a.conv_w[j * NUP + n0 + e]; wb[j][e] = a.conv_w[j * NUP + DFF + n0 + e]; }
#pragma unroll
        for (int e = 0; e < 8; ++e) { ca[e] = a.conv_b[n0 + e]; cb[e] = a.conv_b[DFF + n0 + e]; }
        float a2[8], a1[8], b2[8], b1[8];
        const bool seq_start = (r0 & (SEQ - 1)) == 0;
#pragma unroll
        for (int e = 0; e < 8; ++e) { a2[e] = a1[e] = b2[e] = b1[e] = 0.f; }
        if (!seq_start) {
            const u32x4 pa2 = *(const u32x4*)(w.upraw + (size_t)(r0 - 2) * NUP + n0), pb2 = *(const u32x4*)(w.upraw + (size_t)(r0 - 2) * NUP + DFF + n0);
            const u32x4 pa1 = *(const u32x4*)(w.upraw + (size_t)(r0 - 1) * NUP + n0), pb1 = *(const u32x4*)(w.upraw + (size_t)(r0 - 1) * NUP + DFF + n0);
#pragma unroll
            for (int e = 0; e < 4; ++e) { a2[2 * e] = bf_lo(pa2[e]); a2[2 * e + 1] = bf_hi(pa2[e]); b2[2 * e] = bf_lo(pb2[e]); b2[2 * e + 1] = bf_hi(pb2[e]);
                a1[2 * e] = bf_lo(pa1[e]); a1[2 * e + 1] = bf_hi(pa1[e]); b1[2 * e] = bf_lo(pb1[e]); b1[2 * e + 1] = bf_hi(pb1[e]); }
        }
        for (int r = 0; r < 32; ++r) {
            const u32x4 pa = *(const u32x4*)(w.upraw + (size_t)(r0 + r) * NUP + n0), pb = *(const u32x4*)(w.upraw + (size_t)(r0 + r) * NUP + DFF + n0);
            float a0[8], b0[8], res[8];
#pragma unroll
            for (int e = 0; e < 4; ++e) { a0[2 * e] = bf_lo(pa[e]); a0[2 * e + 1] = bf_hi(pa[e]); b0[2 * e] = bf_lo(pb[e]); b0[2 * e + 1] = bf_hi(pb[e]); }
#pragma unroll
            for (int e = 0; e < 8; ++e) {
                const float ya = ca[e] + wa[0][e] * a2[e] + wa[1][e] * a1[e] + wa[2][e] * a0[e];
                const float yb = cb[e] + wb[0][e] * b2[e] + wb[1][e] * b1[e] + wb[2][e] * b0[e];
                res[e] = silu_f(ya) * yb; a2[e] = a1[e]; a1[e] = a0[e]; b2[e] = b1[e]; b1[e] = b0[e];
            }
            u32x4 o; o[0] = pk2(res[0], res[1]); o[1] = pk2(res[2], res[3]); o[2] = pk2(res[4], res[5]); o[3] = pk2(res[6], res[7]);
            *(u32x4*)(w.act + (size_t)(r0 + r) * DFF + n0) = o;
        }
    }
}

__global__ void __launch_bounds__(512, 2) fwd_mega(Args a) {
    extern __shared__ __attribute__((aligned(16))) unsigned char shm[];
    cg::grid_group grid = cg::this_grid();
    const WS w = make_ws(a.ws);
    const int lo = a.ph_lo, hi = a.ph_hi; const bool coop = a.coop != 0;
#define PH_BEGIN(n) if (lo <= (n) && (n) < hi) {
#define PH_END(n) if (coop && (n) + 1 < hi) grid.sync(); }
    PH_BEGIN(0) phase0(a, w, shm); PH_END(0)
    PH_BEGIN(1) rms_phase(a, w, shm, a.x, a.norm1_g, 0, 2048, w.hbuf, true); PH_END(1)
    PH_BEGIN(2) { EpiProj E; E.O = w.proj; run_gemm(shm, w.hbuf, w.wt_in, NTOK, NP, 2048, E); } PH_END(2)
    PH_BEGIN(3) mixer_a_phase(a, w, shm); kv_prep_phase(a, w, shm); indexer_phase(a, w, shm); PH_END(3)
    PH_BEGIN(4) attn_phase(a, w); PH_END(4)
    PH_BEGIN(5) { EpiGate E; E.T = w.merged; E.proj = w.proj; E.gcol = C_GA; E.first = 1; run_gemm(shm, w.ya, w.wt_a, NTOK, 2048, 1024, E);
                  EpiGate E2; E2.T = w.merged; E2.proj = w.proj; E2.gcol = C_GB; E2.first = 0; run_gemm(shm, w.yb, w.wt_b, NTOK, 2048, 1024, E2); } PH_END(5)
    PH_BEGIN(6) { EpiRes E; E.O = a.out; E.R = a.x; E.mod = w.mod; E.goff = 4096; E.row_off = 0; run_gemm(shm, w.merged, w.wt_out, NTOK, 2048, 2048, E); } PH_END(6)
    PH_BEGIN(7) rms_phase(a, w, shm, a.out, a.norm2_g, 6144, 8192, w.hbuf, false); PH_END(7)
#define FFN_HALF(half, pb) \
    PH_BEGIN(pb) { EpiRaw E; E.O = w.upraw; E.ldc = NUP; run_gemm(shm, w.hbuf + (size_t)(half) * HALF_TOK * 2048, w.wt_up, HALF_TOK, NUP, 2048, E); } PH_END(pb) \
    PH_BEGIN(pb + 1) convact_phase(a, w); PH_END(pb + 1) \
    PH_BEGIN(pb + 2) { EpiRes E; E.O = a.out; E.R = a.out; E.mod = w.mod; E.goff = 10240; E.row_off = (half) * HALF_TOK; run_gemm(shm, w.act, w.wt_dn, HALF_TOK, 2048, DFF, E); } PH_END(pb + 2)
    FFN_HALF(0, 8)
    FFN_HALF(1, 11)
}

extern "C" void kernel_launch(void* const* d_in, const int* in_sizes, int n_in, void* d_out, int out_size, void* d_ws, size_t ws_size, hipStream_t stream) {
    static int grid = 0;
    if (grid == 0) {
        int dev = 0, cus = 0, per_cu = 0;
        hipGetDevice(&dev); hipDeviceGetAttribute(&cus, hipDeviceAttributeMultiprocessorCount, dev);
        if (hipFuncSetAttribute((const void*)fwd_mega, hipFuncAttributeMaxDynamicSharedMemorySize, LDS_BYTES) != hipSuccess) fprintf(stderr, "kernel_launch: hipFuncSetAttribute failed\n");
        hipOccupancyMaxActiveBlocksPerMultiprocessor(&per_cu, (const void*)fwd_mega, 512, LDS_BYTES);
        (void)hipGetLastError();
        if (per_cu < 1) per_cu = 1;
        grid = cus * 1;
        if (ws_size < WS_END) fprintf(stderr, "kernel_launch: workspace too small: %zu < %zu\n", ws_size, (size_t)WS_END);
        fprintf(stderr, "kernel_launch: cus %d per_cu %d grid %d ws %zu need %zu\n", cus, per_cu, grid, ws_size, (size_t)WS_END);
    }
    Args a{};
    a.x = (const float*)d_in[0]; a.c = (const float*)d_in[1]; a.w_ada = (const float*)d_in[2]; a.b_ada = (const float*)d_in[3]; a.norm1_g = (const float*)d_in[4]; a.w_in = (const float*)d_in[5];
    a.v_norm_g = (const float*)d_in[6]; a.w_spatial = (const float*)d_in[7]; a.b_spatial = (const float*)d_in[8]; a.q_norm_g = (const float*)d_in[9]; a.k_norm_g = (const float*)d_in[10];
    a.w_proj_a = (const float*)d_in[11]; a.w_proj_b = (const float*)d_in[12]; a.w_out = (const float*)d_in[13]; a.norm2_g = (const float*)d_in[14]; a.w_up = (const float*)d_in[15];
    a.conv_w = (const float*)d_in[16]; a.conv_b = (const float*)d_in[17]; a.w_down = (const float*)d_in[18];
    a.out = (float*)d_out; a.ws = (unsigned char*)d_ws;
#if MULTI_LAUNCH
    a.coop = 0;
    for (int ph = 0; ph < NPH; ++ph) { a.ph_lo = ph; a.ph_hi = ph + 1; hipLaunchKernelGGL(fwd_mega, dim3(grid), dim3(512), LDS_BYTES, stream, a); }
#else
    a.coop = 1; a.ph_lo = 0; a.ph_hi = NPH;
    void* args[] = {&a};
    hipError_t e = hipLaunchCooperativeKernel((const void*)fwd_mega, dim3(grid), dim3(512), args, LDS_BYTES, stream);
    if (e != hipSuccess) fprintf(stderr, "cooperative launch failed: %s (grid %d)\n", hipGetErrorString(e), grid);
#endif
}
```

```cpp
#include <hip/hip_runtime.h>
#include <hip/hip_cooperative_groups.h>
#include <cstdio>
namespace cg = cooperative_groups;
#define MULTI_LAUNCH 0
#define WGM_WIDE 4
#define WGM_NARROW 2
namespace pg8 {
#define PG8_LAS __attribute__((address_space(3)))
typedef unsigned short bf16_t;
typedef short bf16x8 __attribute__((ext_vector_type(8)));
typedef float f32x4 __attribute__((ext_vector_type(4)));
typedef unsigned u32x4 __attribute__((ext_vector_type(4)));
constexpr int BM = 256, BK = 64, HALF = 128, HTB = HALF * BK * 2  , STAGE_BYTES = 8 * HTB, NXCD = 8, WGM = 4;

__host__ __device__ __forceinline__ int lds_byte(int r, int c) { const int st = (r >> 4) * 2 + (c >> 5), rr = r & 15, cc = c & 31, ob = rr * 64 + cc * 2; return st * 1024 + (ob ^ (((ob >> 9) & 1) << 5)); }
__host__ __device__ __forceinline__ void stage_rc(int b, int& R, int& C) { const int st = b / 1024, sb = b % 1024, swz = sb ^ (((sb >> 9) & 1) << 5); R = (st >> 1) * 16 + swz / 64; C = (st & 1) * 32 + (swz % 64) / 2; }
__host__ __device__ __forceinline__ int perm32(int rho) { const int n = rho >> 4, i = rho & 15; return 8 * (i >> 2) + 4 * n + (i & 3); }

struct Unit { int pm, pn; };
struct Gemm { const bf16_t* A; const bf16_t* Bt; int M, N, K; };

struct StaticOrder {
    int nM, nN, nwg, G, c, wgm = WGM;
    __host__ __device__ void init(int M, int N, int G_, int c_) { nM = M / BM; nN = N / BM; nwg = nM * nN; G = G_; c = c_; }
    __host__ __device__ bool next(int i, Unit& u) const {
        const long L = (long)i * G + c; if (L >= nwg) return false;
        int wgid = (int)L; { const int q = nwg / NXCD, r = nwg % NXCD, xcd = wgid % NXCD, off = wgid / NXCD; wgid = (xcd < r ? xcd * (q + 1) : r * (q + 1) + (xcd - r) * q) + off; }
        const int nig = wgm * nN, gid = wgid / nig, fm = gid * wgm, gsz = (nM - fm) < wgm ? (nM - fm) : wgm;
        u.pm = fm + ((wgid % nig) % gsz); u.pn = (wgid % nig) / gsz; return true;
    }
    __device__ __forceinline__ void a_ready(const Unit&) const {}
    __device__ __forceinline__ void done(const Unit&) const {}
};
__device__ __forceinline__ unsigned cvt_pk_bf16(float lo, float hi) { unsigned r; asm volatile("v_cvt_pk_bf16_f32 %0, %1, %2" : "=v"(r) : "v"(lo), "v"(hi)); return r; }

template <class Epi, class Sched, bool STAMP = false>
__device__ __forceinline__ void gemm_phase(PG8_LAS unsigned char* lds, const Gemm g, const Sched& S, const Epi& E, unsigned long long* stamps) {
    const int tid = threadIdx.x, wid = __builtin_amdgcn_readfirstlane(tid >> 6), lane = tid & 63, wr = wid >> 2, wc = wid & 3, fr = lane & 15, fq = lane >> 4;
    const int K = g.K, nt = K / BK;
    int ts_lo = 0, ts_hi = 0, nts = 0; const unsigned long long rt_entry = STAMP ? (unsigned long long)wall_clock64() : 0ull;
#define PG8_STAMP() do { if (STAMP && wid == 0 && nts < 64) { const unsigned long long _c = (unsigned long long)clock64(); \
        ts_lo = (lane == nts) ? (int)(unsigned)_c : ts_lo; ts_hi = (lane == nts) ? (int)(unsigned)(_c >> 32) : ts_hi; ++nts; } } while (0)
    PG8_STAMP();
    unsigned voffA[2], voffB[2];
#pragma unroll
    for (int i = 0; i < 2; ++i) { int R, C; stage_rc(tid * 16 + i * 8192, R, C); const int Rb = Epi::PERM ? ((R & ~31) + perm32(R & 31)) : R;
        voffA[i] = (unsigned)(R * K + C) * 2u; voffB[i] = (unsigned)(Rb * K + C) * 2u; }
    const size_t kstep = (size_t)(BK * 2);
    const size_t hstep = (size_t)HALF * K * 2;
    const size_t tstep = 2 * hstep;
    const unsigned ldsw = (unsigned)wid * 1024u;
    const int aoff = lds_byte(wr * 64 + fr, fq * 8), boff = lds_byte(wc * 32 + fr, fq * 8);
#define PG8_SA(b, h) (((b) * 2 + (h)) * HTB)
#define PG8_SB(b, h) ((4 + (b) * 2 + (h)) * HTB)
#define PG8_STAGE(bufoff, gbase, voff) do { _Pragma("unroll") for (int _i = 0; _i < 2; ++_i) \
        __builtin_amdgcn_global_load_lds((const unsigned*)((const char*)(gbase) + (voff)[_i]), (PG8_LAS unsigned*)(lds + (bufoff) + ldsw + _i * 8192), 16, 0, 0); } while (0)
#define PG8_LDA(dst, b, h) do { _Pragma("unroll") for (int m = 0; m < 4; ++m) _Pragma("unroll") for (int k = 0; k < 2; ++k) dst[m][k] = *(const PG8_LAS bf16x8*)(lds + PG8_SA(b, h) + aoff + m * 2048 + k * 1024); } while (0)
#define PG8_LDB(dst, b, h) do { _Pragma("unroll") for (int n = 0; n < 2; ++n) _Pragma("unroll") for (int k = 0; k < 2; ++k) dst[n][k] = *(const PG8_LAS bf16x8*)(lds + PG8_SB(b, h) + boff + n * 2048 + k * 1024); } while (0)
#define PG8_MMA(ai, bj, At, Bt) do { __builtin_amdgcn_s_setprio(1); _Pragma("unroll") for (int m = 0; m < 4; ++m) _Pragma("unroll") for (int n = 0; n < 2; ++n) _Pragma("unroll") for (int k = 0; k < 2; ++k) \
        acc[ai][bj][m][n] = __builtin_amdgcn_mfma_f32_16x16x32_bf16(Bt[n][k], At[m][k], acc[ai][bj][m][n], 0, 0, 0); __builtin_amdgcn_s_setprio(0); } while (0)
#define PG8_WAIT_V(n) asm volatile("s_waitcnt vmcnt(" #n ")" ::: "memory")
#define PG8_WAIT_L(n) asm volatile("s_waitcnt lgkmcnt(" #n ")" ::: "memory")
#define PG8_BAR __builtin_amdgcn_s_barrier()
#define PG8_SCHED __builtin_amdgcn_sched_barrier(0)
    Unit cur, nxt; int ui = 0;
    if (!S.next(0, cur)) return;
    f32x4 acc[2][2][4][2];
#pragma unroll
    for (int a = 0; a < 2; ++a)
#pragma unroll
        for (int b = 0; b < 2; ++b)
#pragma unroll
            for (int m = 0; m < 4; ++m)
#pragma unroll
                for (int n = 0; n < 2; ++n) acc[a][b][m][n] = (f32x4){0.f, 0.f, 0.f, 0.f};
    bf16x8 At[4][2], B0[2][2], B1[2][2];
    const char* cA = (const char*)g.A + (size_t)cur.pm * tstep; const char* cB = (const char*)g.Bt + (size_t)cur.pn * tstep;
    S.a_ready(cur);
    PG8_STAGE(PG8_SB(0, 0), cB, voffB); PG8_STAGE(PG8_SA(0, 0), cA, voffA); PG8_STAGE(PG8_SB(0, 1), cB + hstep, voffB); PG8_STAGE(PG8_SA(0, 1), cA + hstep, voffA);
    if (wr == 1) PG8_BAR;
    PG8_WAIT_V(4); PG8_BAR;
    PG8_STAGE(PG8_SB(1, 0), cB + kstep, voffB); PG8_STAGE(PG8_SA(1, 0), cA + kstep, voffA); PG8_STAGE(PG8_SB(1, 1), cB + hstep + kstep, voffB);
    PG8_WAIT_V(6); PG8_BAR;
    PG8_STAMP();
    for (;;) {
        const bool has_next = S.next(ui + 1, nxt);
        const char* nA = has_next ? (const char*)g.A + (size_t)nxt.pm * tstep : cA; const char* nB = has_next ? (const char*)g.Bt + (size_t)nxt.pn * tstep : cB;
        for (int t = 0; t < nt; t += 2) {
            const bool last = (t == nt - 2);
            const char* a1 = cA + (size_t)(t + 1) * kstep;
            const char* a2 = last ? nA : cA + (size_t)(t + 2) * kstep; const char* b2 = last ? nB : cB + (size_t)(t + 2) * kstep;
            const char* a3 = a2 + kstep; const char* b3 = b2 + kstep;
            if (last && has_next) S.a_ready(nxt);
            PG8_LDB(B0, 0, 0); PG8_SCHED; PG8_LDA(At, 0, 0); PG8_STAGE(PG8_SA(1, 1), a1 + hstep, voffA);
            PG8_WAIT_L(8); PG8_BAR; PG8_WAIT_L(0); PG8_MMA(0, 0, At, B0); PG8_BAR; PG8_SCHED;
            PG8_LDB(B1, 0, 1); PG8_STAGE(PG8_SB(0, 0), b2, voffB);
            PG8_BAR; PG8_WAIT_L(0); PG8_MMA(0, 1, At, B1); PG8_BAR;
            PG8_LDA(At, 0, 1); PG8_STAGE(PG8_SA(0, 0), a2, voffA);
            PG8_BAR; PG8_WAIT_L(0); PG8_MMA(1, 0, At, B0); PG8_BAR; PG8_SCHED;
            PG8_STAGE(PG8_SB(0, 1), b2 + hstep, voffB);
            PG8_WAIT_V(6); PG8_BAR; PG8_MMA(1, 1, At, B1); PG8_BAR;
            PG8_LDB(B0, 1, 0); PG8_SCHED; PG8_LDA(At, 1, 0); PG8_STAGE(PG8_SA(0, 1), a2 + hstep, voffA);
            PG8_WAIT_L(8); PG8_BAR; PG8_WAIT_L(0); PG8_MMA(0, 0, At, B0); PG8_BAR; PG8_SCHED;
            PG8_LDB(B1, 1, 1); PG8_STAGE(PG8_SB(1, 0), b3, voffB);
            PG8_BAR; PG8_WAIT_L(0); PG8_MMA(0, 1, At, B1); PG8_BAR;
            PG8_LDA(At, 1, 1); PG8_STAGE(PG8_SA(1, 0), a3, voffA);
            PG8_BAR; PG8_WAIT_L(0); PG8_MMA(1, 0, At, B0); PG8_BAR; PG8_SCHED;
            PG8_STAGE(PG8_SB(1, 1), b3 + hstep, voffB);
            PG8_WAIT_V(6); PG8_BAR; PG8_MMA(1, 1, At, B1); PG8_BAR;
        }
        PG8_STAMP();
        if constexpr (!Epi::AFTER_DRAIN) { E(acc, cur, wr, wc, fr, fq); S.done(cur); }
        PG8_STAMP();
        if (!has_next) break;
#pragma unroll
        for (int a = 0; a < 2; ++a)
#pragma unroll
            for (int b = 0; b < 2; ++b)
#pragma unroll
                for (int m = 0; m < 4; ++m)
#pragma unroll
                    for (int n = 0; n < 2; ++n) acc[a][b][m][n] = (f32x4){0.f, 0.f, 0.f, 0.f};
        cur = nxt; cA = nA; cB = nB; ++ui;
    }
    PG8_WAIT_V(0);
    if (wr == 0) PG8_BAR;
    PG8_BAR;
    if constexpr (Epi::AFTER_DRAIN) { E.fused(acc, cur, wr, wc, fr, fq, lds, wid, lane); S.done(cur); }
    PG8_STAMP();
    if (STAMP && wid == 0) { stamps[lane] = lane < nts ? (((unsigned long long)(unsigned)ts_hi << 32) | (unsigned)ts_lo) : 0ull;
        if (lane == 62) stamps[62] = rt_entry; if (lane == 63) stamps[63] = (unsigned long long)wall_clock64(); }
#undef PG8_STAMP
#undef PG8_SA
#undef PG8_SB
#undef PG8_STAGE
#undef PG8_LDA
#undef PG8_LDB
#undef PG8_MMA
#undef PG8_WAIT_V
#undef PG8_WAIT_L
#undef PG8_BAR
#undef PG8_SCHED
}
}
#define XB_TMO      128
#define XB_XCNT(j)  (256  + 64 * (j))
#define XB_XSUB(j)  (1280 + 64 * (j))
#define XB_XGEN(j)  (2304 + 64 * (j))
#define XB_TOP      3328
#define XB_TOPGEN   3392
#define XCD_BAR_WORDS 3456
#define XB_SPIN_CAP (1u << 18)
#define XLAS __attribute__((address_space(3)))

__device__ __forceinline__ unsigned xb_ld(unsigned* p)              { return __hip_atomic_load(p, __ATOMIC_RELAXED, __HIP_MEMORY_SCOPE_AGENT); }
__device__ __forceinline__ unsigned xb_add(unsigned* p, unsigned v) { return __hip_atomic_fetch_add(p, v, __ATOMIC_RELAXED, __HIP_MEMORY_SCOPE_AGENT); }
__device__ __forceinline__ unsigned xb_xcc_id() { return (unsigned)__builtin_amdgcn_s_getreg((3 << 11) | 20) & 0xFu; }
#define XB_SPIN(cond, bar) do { unsigned _sp = 0; while (cond) { __builtin_amdgcn_s_sleep(1); \
    if ((++_sp & 255u) == 0u) { if (xb_ld(&(bar)[XB_TMO])) break; if (_sp > XB_SPIN_CAP) { atomicAdd(&(bar)[XB_TMO], 1u); break; } } } } while (0)

struct XcdBarrier {
    unsigned* bar; unsigned x;
    volatile XLAS unsigned* st;
};

__device__ __forceinline__ XcdBarrier xcd_barrier_post(unsigned* bar, volatile XLAS unsigned* st) {
    XcdBarrier b; b.bar = bar; b.x = xb_xcc_id(); b.st = st;
    if (threadIdx.x == 0) (void)xb_add(&bar[XB_XCNT(b.x)], 1u);
    return b;
}
__device__ __forceinline__ void xcd_barrier_complete(unsigned* bar, unsigned x, unsigned& nloc, unsigned& nx) {
    const unsigned G = gridDim.x * gridDim.y * gridDim.z;
    unsigned sum, cnt, mine, sp = 0u;
    for (;;) {
        sum = 0u; cnt = 0u; mine = 0u;
#pragma unroll
        for (unsigned j = 0; j < 16; ++j) { const unsigned c = xb_ld(&bar[XB_XCNT(j)]); sum += c; cnt += (c > 0u) ? 1u : 0u; mine = (j == x) ? c : mine; }
        if (sum == G) break;
        __builtin_amdgcn_s_sleep(1);
        if ((++sp & 255u) == 0u) { if (xb_ld(&bar[XB_TMO])) break; if (sp > XB_SPIN_CAP) { atomicAdd(&bar[XB_TMO], 1u); break; } }
    }
    nloc = mine > 0u ? mine : 1u; nx = cnt > 0u ? cnt : 1u;
}

__device__ __forceinline__ void xcd_barrier(const XcdBarrier& b) {
    asm volatile("s_waitcnt vmcnt(0)" ::: "memory");
    __syncthreads();
    if (threadIdx.x == 0) {
        unsigned* bar = b.bar;
        __builtin_amdgcn_s_waitcnt(0);
        unsigned nloc = b.st[0], nx = b.st[1];
        if (nloc == 0u) { xcd_barrier_complete(bar, b.x, nloc, nx); b.st[0] = nloc; b.st[1] = nx; }
        const unsigned old = xb_add(&bar[XB_XSUB(b.x)], 1u);
        const unsigned gen = old / nloc;
        if (old + 1u == (gen + 1u) * nloc) {
            __builtin_amdgcn_fence(__ATOMIC_RELEASE, "agent");
            asm volatile("s_waitcnt vmcnt(0)" ::: "memory");
            const unsigned og = xb_add(&bar[XB_TOP], 1u);
            const unsigned tg = og / nx;
            if (og + 1u == (tg + 1u) * nx) xb_add(&bar[XB_TOPGEN], 1u);
            else XB_SPIN(xb_ld(&bar[XB_TOPGEN]) == tg, bar);
            __builtin_amdgcn_fence(__ATOMIC_ACQUIRE, "agent");
            xb_add(&bar[XB_XGEN(b.x)], 1u);
            asm volatile("s_waitcnt vmcnt(0)" ::: "memory");
        } else {
            XB_SPIN(xb_ld(&bar[XB_XGEN(b.x)]) == gen, bar);
            __builtin_amdgcn_fence(__ATOMIC_ACQUIRE, "agent");
            asm volatile("s_waitcnt vmcnt(0)" ::: "memory");
        }
    }
    __syncthreads();
}
typedef unsigned short u16; typedef unsigned int u32;
typedef u32 u32x2 __attribute__((ext_vector_type(2)));
typedef u32 u32x4 __attribute__((ext_vector_type(4)));
typedef float f32x16 __attribute__((ext_vector_type(16)));
typedef __bf16 bf16v2 __attribute__((ext_vector_type(2)));
using pg8::bf16x8; using pg8::f32x4;
#define DI __device__ __forceinline__
DI u32 pk2(float a, float b) { bf16v2 v = {(__bf16)a, (__bf16)b}; return __builtin_bit_cast(u32, v); }
DI float bf_lo(u32 w) { return __uint_as_float(w << 16); }
DI float bf_hi(u32 w) { return __uint_as_float(w & 0xffff0000u); }
DI float bf2f(u16 h) { return __uint_as_float((u32)h << 16); }
DI float fast_sigmoid(float x) { return __builtin_amdgcn_rcpf(1.0f + __builtin_amdgcn_exp2f(-1.44269504089f * x)); }
DI float gelu_tanh(float x) { const float z = 0.7978845608f * (x + 0.044715f * x * x * x); return x * fast_sigmoid(2.0f * z); }
DI float silu_f(float x) { return x * fast_sigmoid(x); }

constexpr int NB = 16, SEQ = 2048, DM = 2048, NTOK = NB * SEQ;
constexpr int NP = 8960;
constexpr int C_U = 0, C_VA = 1024, C_Q = 2048, C_QI = 3072, C_GA = 4096, C_GB = 6144, C_K = 8192, C_VB = 8448, C_KI = 8704, C_WI = 8768;
constexpr int DFF = 5632, NUP = 11264, NMOD = 12288, KSPL = 32;
constexpr int HALF_TOK = NTOK / 2;
constexpr float EPSN = 1e-6f;
constexpr int LDS_BAR_OFF = 131072 + 3 * 8192, LDS_BYTES = LDS_BAR_OFF + 16;
constexpr int NPH = 11;

constexpr size_t WS_WT_IN = 0;
constexpr size_t WS_WT_A = WS_WT_IN + (size_t)NP * 2048 * 2;
constexpr size_t WS_WT_B = WS_WT_A + (size_t)2048 * 1024 * 2;
constexpr size_t WS_WT_OUT = WS_WT_B + (size_t)2048 * 1024 * 2;
constexpr size_t WS_WT_UP = WS_WT_OUT + (size_t)2048 * 2048 * 2;
constexpr size_t WS_WT_DN = WS_WT_UP + (size_t)NUP * 2048 * 2;
constexpr size_t WS_MODP = WS_WT_DN + (size_t)2048 * DFF * 2;
constexpr size_t WS_MOD = WS_MODP + (size_t)KSPL * NB * NMOD * 4;
constexpr size_t WS_MASK = WS_MOD + (size_t)NB * NMOD * 4;
constexpr size_t WS_KN = WS_MASK + (size_t)NTOK * 64 * 4;
constexpr size_t WS_VT = WS_KN + (size_t)NTOK * 256 * 2;
constexpr size_t WS_HBUF = WS_VT + (size_t)NTOK * 256 * 2;
constexpr size_t WS_MERGED = WS_HBUF + (size_t)NTOK * 2048 * 2;
constexpr size_t WS_PROJ = WS_MERGED + (size_t)NTOK * 2048 * 2;
constexpr size_t WS_ACT = WS_PROJ;
constexpr size_t WS_HALO = WS_ACT + (size_t)NTOK * DFF * 2;
constexpr size_t WS_BAR = WS_PROJ + (size_t)NTOK * NP * 2;
constexpr size_t WS_END = WS_BAR + 16384;
constexpr size_t WS_X1B = WS_HALO + (size_t)513 * 4 * NUP * 2;
static_assert(WS_X1B + (size_t)NTOK * 2048 * 2 <= WS_PROJ + (size_t)NTOK * NP * 2, "ws alias");

struct Args {
    const float *x, *c, *w_ada, *b_ada, *norm1_g, *w_in, *v_norm_g, *w_spatial, *b_spatial, *q_norm_g, *k_norm_g, *w_proj_a, *w_proj_b, *w_out, *norm2_g, *w_up, *conv_w, *conv_b, *w_down;
    float* out; unsigned char* ws; int ph_lo, ph_hi, coop, pad;
};
struct WS {
    u16 *wt_in, *wt_a, *wt_b, *wt_out, *wt_up, *wt_dn; float *modp, *mod; u32* mask; u16 *kn, *vt, *hbuf, *ya, *yb, *merged, *proj, *halo, *act, *x1b;
};
DI WS make_ws(unsigned char* p) {
    WS w; w.wt_in = (u16*)(p + WS_WT_IN); w.wt_a = (u16*)(p + WS_WT_A); w.wt_b = (u16*)(p + WS_WT_B); w.wt_out = (u16*)(p + WS_WT_OUT); w.wt_up = (u16*)(p + WS_WT_UP); w.wt_dn = (u16*)(p + WS_WT_DN);
    w.modp = (float*)(p + WS_MODP); w.mod = (float*)(p + WS_MOD); w.mask = (u32*)(p + WS_MASK); w.kn = (u16*)(p + WS_KN); w.vt = (u16*)(p + WS_VT); w.hbuf = (u16*)(p + WS_HBUF);
    w.ya = w.hbuf; w.yb = w.hbuf + (size_t)NTOK * 1024; w.merged = (u16*)(p + WS_MERGED); w.proj = (u16*)(p + WS_PROJ); w.halo = (u16*)(p + WS_HALO); w.act = (u16*)(p + WS_ACT); w.x1b = (u16*)(p + WS_X1B);
    return w;
}

DI int map_in(int n) {
    if (n < 3072) return n;
    if (n < 3328) return n - 3072 + C_K;
    if (n < 3584) return n - 3328 + C_VB;
    if (n < 4608) return n - 3584 + C_QI;
    if (n < 4672) return n - 4608 + C_KI;
    if (n < 4688) return n - 4672 + C_WI;
    if (n < 6736) return n - 4688 + C_GA;
    return n - 6736 + C_GB;
}
DI int conv_dst_row(int mode, int n2) {
    return (mode == 1) ? map_in(n2) : (mode == 2) ? ((n2 < DFF) ? ((n2 >> 7) * 256 + (n2 & 127)) : (((n2 - DFF) >> 7) * 256 + 128 + ((n2 - DFF) & 127))) : n2;
}
DI void conv_tiles4(const float* __restrict__ src, u16* __restrict__ dst, int K, int N, int nkt, int t0, int tstep, int cnt, int mode, float* tile) {
    const int tid = threadIdx.x, tx = tid & 63, ty = tid >> 6;
    float v[4][8];
#pragma unroll
    for (int q = 0; q < 4; ++q) {
        const int t = t0 + q * tstep;
        if (t < cnt) { const int kt = t % nkt, nt = t / nkt, n = nt * 64 + tx;
#pragma unroll
            for (int i = 0; i < 8; ++i) v[q][i] = (n < N) ? __builtin_nontemporal_load(src + (size_t)(kt * 64 + ty * 8 + i) * N + n) : 0.f; }
    }
#pragma unroll
    for (int q = 0; q < 4; ++q) {
        if (t0 + q * tstep < cnt) {
#pragma unroll
            for (int i = 0; i < 8; ++i) tile[q * 4160 + (ty * 8 + i) * 65 + tx] = v[q][i]; }
    }
    __syncthreads();
    const int nl = tid >> 3, kc = tid & 7;
#pragma unroll
    for (int q = 0; q < 4; ++q) {
        const int t = t0 + q * tstep;
        if (t < cnt) { const int kt = t % nkt, nt = t / nkt, n2 = nt * 64 + nl;
            if (n2 < N) {
                const int dn = conv_dst_row(mode, n2);
                u32x4 o;
#pragma unroll
                for (int e = 0; e < 4; ++e) o[e] = pk2(tile[q * 4160 + (kc * 8 + 2 * e) * 65 + nl], tile[q * 4160 + (kc * 8 + 2 * e + 1) * 65 + nl]);
                *(u32x4*)(dst + (size_t)dn * K + kt * 64 + kc * 8) = o;
            } }
    }
    __syncthreads();
}
DI void convert_wup_tail(const Args& a, const WS& w, unsigned char* lds, int cid) {
    if (gridDim.x != 256 || cid < 128) return;
    float* tile = (float*)lds;
    const int nkt = 2048 / 64, cnt = nkt * (NUP / 64);
    for (int t = cid - 128; t < cnt; t += 4 * 128) conv_tiles4(a.w_up, w.wt_up, 2048, NUP, nkt, t, 128, cnt, 2, tile);
}
DI void phase0(const Args& a, const WS& w, unsigned char* lds) {
    float* tile = (float*)lds;
    const float* srcs[6] = {a.w_in, a.w_proj_a, a.w_proj_b, a.w_out, a.w_up, a.w_down};
    u16* dsts[6] = {w.wt_in, w.wt_a, w.wt_b, w.wt_out, w.wt_up, w.wt_dn};
    const int Ks[6] = {2048, 1024, 1024, 2048, 2048, DFF}, Ns[6] = {8784, 2048, 2048, 2048, NUP, 2048};
    int base = 0;
    const bool defer_up = (gridDim.x == 256);
#pragma unroll
    for (int i = 0; i < 6; ++i) {
        if (i == 4 && defer_up) continue;
        const int nkt = Ks[i] / 64, nnt = (Ns[i] + 63) / 64, cnt = nkt * nnt;
        int first = (int)blockIdx.x - (base % (int)gridDim.x); if (first < 0) first += gridDim.x;
        for (int t = first; t < cnt; t += 4 * gridDim.x) conv_tiles4(srcs[i], dsts[i], Ks[i], Ns[i], nkt, t, (int)gridDim.x, cnt, (i == 0) ? 1 : ((i == 4) ? 2 : 0), tile);
        base += cnt;
    }
    { u32x4 z = {0u, 0u, 0u, 0u}; u32x4* p = (u32x4*)(w.wt_in + (size_t)8784 * 2048); const int n16 = (NP - 8784) * 2048 / 8;
      for (int i = blockIdx.x * 512 + threadIdx.x; i < n16; i += gridDim.x * 512) p[i] = z; }
    float* sl = (float*)lds;
    for (int item = blockIdx.x; item < KSPL * 24; item += gridDim.x) {
        const int ks = item / 24, nc = item % 24;
        __syncthreads();
        for (int e = threadIdx.x; e < 1024; e += 512) { const int k = e >> 4, b = e & 15; const float cv = a.c[b * 2048 + ks * 64 + k]; sl[e] = silu_f(cv); }
        __syncthreads();
        const int n = nc * 512 + threadIdx.x;
        float acc[16];
#pragma unroll
        for (int b = 0; b < 16; ++b) acc[b] = 0.f;
        const float* wp = a.w_ada + (size_t)(ks * 64) * NMOD + n;
#pragma unroll 1
        for (int kb = 0; kb < 64; kb += 32) {
            float wv[32];
#pragma unroll
            for (int k = 0; k < 32; ++k) wv[k] = __builtin_nontemporal_load(wp + (size_t)(kb + k) * NMOD);
#pragma unroll
            for (int k = 0; k < 32; ++k) {
                const f32x4* s4 = (const f32x4*)(sl + (kb + k) * 16);
#pragma unroll
                for (int q = 0; q < 4; ++q) { const f32x4 s = s4[q]; acc[4 * q] += s[0] * wv[k]; acc[4 * q + 1] += s[1] * wv[k]; acc[4 * q + 2] += s[2] * wv[k]; acc[4 * q + 3] += s[3] * wv[k]; }
            }
        }
#pragma unroll
        for (int b = 0; b < 16; ++b) w.modp[((size_t)ks * 16 + b) * NMOD + n] = acc[b];
    }
    __syncthreads();
}

template <bool INBF> DI void rms_phase(const Args& a, const WS& w, unsigned char* lds, const void* __restrict__ xin_v, const float* __restrict__ g, int sh_off, int sc_off, u16* __restrict__ hout, bool finalize) {
    const float* xin = (const float*)xin_v; const u16* xinb = (const u16*)xin_v;
    float* gs = (float*)lds; float* shs = gs + 2048;
    const int lane = threadIdx.x & 63, wave = __builtin_amdgcn_readfirstlane(threadIdx.x >> 6);
    if (finalize) {
        for (int e = blockIdx.x * 512 + threadIdx.x; e < NB * NMOD; e += gridDim.x * 512) {
            const int b = e / NMOD, n = e % NMOD; float s = a.b_ada[n];
            float pv[KSPL];
#pragma unroll
            for (int ks = 0; ks < KSPL; ++ks) pv[ks] = w.modp[((size_t)ks * 16 + b) * NMOD + n];
#pragma unroll
            for (int ks = 0; ks < KSPL; ++ks) s += pv[ks];
            w.mod[e] = s;
        }
    }
    for (int rb = blockIdx.x; rb < NTOK / 128; rb += gridDim.x) {
        const int b = rb / 16;
        __syncthreads();
        for (int c = threadIdx.x; c < 2048; c += 512) {
            float sc = a.b_ada[sc_off + c], sh = a.b_ada[sh_off + c];
            if (finalize) {
                float p0[KSPL], p1[KSPL];
#pragma unroll
                for (int ks = 0; ks < KSPL; ++ks) { const float* mp = w.modp + ((size_t)ks * 16 + b) * NMOD; p0[ks] = mp[sc_off + c]; p1[ks] = mp[sh_off + c]; }
#pragma unroll
                for (int ks = 0; ks < KSPL; ++ks) { sc += p0[ks]; sh += p1[ks]; }
            } else { sc = w.mod[(size_t)b * NMOD + sc_off + c]; sh = w.mod[(size_t)b * NMOD + sh_off + c]; }
            gs[c] = g[c] * (1.0f + sc); shs[c] = sh;
        }
        __syncthreads();
        f32x4 nx[8];
        if (!INBF) { const f32x4* xp = (const f32x4*)(xin + ((size_t)rb * 128 + wave * 16) * 2048);
#pragma unroll
          for (int i = 0; i < 8; ++i) nx[i] = __builtin_nontemporal_load(xp + i * 64 + lane); }
        u32x4 nb[4];
        if (INBF) { const u32x4* xp = (const u32x4*)(xinb + ((size_t)rb * 128 + wave * 16) * 2048);
#pragma unroll
          for (int i = 0; i < 4; ++i) nb[i] = xp[i * 64 + lane]; }
#pragma unroll 1
        for (int r = 0; r < 16; ++r) {
            const size_t row = (size_t)rb * 128 + wave * 16 + r;
            f32x4 v[8]; float ss = 0.f;
            if (!INBF) {
#pragma unroll
                for (int i = 0; i < 8; ++i) v[i] = nx[i];
                if (r + 1 < 16) { const f32x4* xp = (const f32x4*)(xin + (row + 1) * 2048);
#pragma unroll
                    for (int i = 0; i < 8; ++i) nx[i] = __builtin_nontemporal_load(xp + i * 64 + lane); }
            } else {
#pragma unroll
                for (int i = 0; i < 4; ++i) { v[2 * i] = (f32x4){bf_lo(nb[i][0]), bf_hi(nb[i][0]), bf_lo(nb[i][1]), bf_hi(nb[i][1])}; v[2 * i + 1] = (f32x4){bf_lo(nb[i][2]), bf_hi(nb[i][2]), bf_lo(nb[i][3]), bf_hi(nb[i][3])}; }
                if (r + 1 < 16) { const u32x4* xp = (const u32x4*)(xinb + (row + 1) * 2048);
#pragma unroll
                    for (int i = 0; i < 4; ++i) nb[i] = xp[i * 64 + lane]; }
            }
#pragma unroll
            for (int i = 0; i < 8; ++i) ss += v[i][0] * v[i][0] + v[i][1] * v[i][1] + v[i][2] * v[i][2] + v[i][3] * v[i][3];
#pragma unroll
            for (int o = 32; o >= 1; o >>= 1) ss += __shfl_xor(ss, o);
            const float rstd = rsqrtf(ss * (1.0f / 2048.0f) + EPSN);
#pragma unroll
            for (int i = 0; i < 8; ++i) {
                const int col = INBF ? (((i >> 1) * 64 + lane) * 8 + (i & 1) * 4) : ((i * 64 + lane) * 4); const f32x4 gg = *(const f32x4*)(gs + col), hh = *(const f32x4*)(shs + col);
                u32x2 o; o[0] = pk2(v[i][0] * rstd * gg[0] + hh[0], v[i][1] * rstd * gg[1] + hh[1]); o[1] = pk2(v[i][2] * rstd * gg[2] + hh[2], v[i][3] * rstd * gg[3] + hh[3]);
                *(u32x2*)(hout + row * 2048 + col) = o;
            }
        }
    }
    __syncthreads();
}
using pg8::Unit; using pg8::BM; using pg8::HALF;
struct EpiProj {
    static constexpr bool PERM = true, AFTER_DRAIN = false;
    u16* O;
    __device__ __forceinline__ void operator()(const f32x4 (&acc)[2][2][4][2], const Unit& u, int wr, int wc, int fr, int fq) const {
        const int row0 = u.pm * BM + wr * 64 + fr, col0 = u.pn * BM + wc * 32 + 8 * fq;
        const int mode = (u.pn < 8) ? 1 : ((u.pn >= 16 && u.pn < 32) ? 2 : 0);
#pragma unroll
        for (int ai = 0; ai < 2; ++ai)
#pragma unroll
            for (int m = 0; m < 4; ++m) { u16* rowp = O + (size_t)(row0 + ai * HALF + m * 16) * NP + col0;
#pragma unroll
                for (int bj = 0; bj < 2; ++bj) { float v[8];
#pragma unroll
                    for (int e = 0; e < 4; ++e) { v[e] = acc[ai][bj][m][0][e]; v[4 + e] = acc[ai][bj][m][1][e]; }
                    if (mode == 1) {
#pragma unroll
                        for (int e = 0; e < 8; ++e) v[e] = gelu_tanh(v[e]);
                    } else if (mode == 2) {
#pragma unroll
                        for (int e = 0; e < 8; ++e) v[e] = fast_sigmoid(v[e]);
                    }
                    u32x4 o; o[0] = pk2(v[0], v[1]); o[1] = pk2(v[2], v[3]); o[2] = pk2(v[4], v[5]); o[3] = pk2(v[6], v[7]);
                    *(u32x4*)(rowp + bj * HALF) = o; } }
    }
};
struct EpiGate {
    static constexpr bool PERM = true, AFTER_DRAIN = false;
    u16* T; const u16* proj; int gcol; int first;
    __device__ __forceinline__ void operator()(const f32x4 (&acc)[2][2][4][2], const Unit& u, int wr, int wc, int fr, int fq) const {
        const int row0 = u.pm * BM + wr * 64 + fr, col0 = u.pn * BM + wc * 32 + 8 * fq;
#pragma unroll
        for (int ai = 0; ai < 2; ++ai)
#pragma unroll
            for (int m = 0; m < 4; ++m) { const size_t row = (size_t)(row0 + ai * HALF + m * 16);
#pragma unroll
                for (int bj = 0; bj < 2; ++bj) { const int col = col0 + bj * HALF;
                    const u32x4 gw = *(const u32x4*)(proj + row * NP + gcol + col);
                    float v[8];
#pragma unroll
                    for (int e = 0; e < 4; ++e) { v[e] = acc[ai][bj][m][0][e]; v[4 + e] = acc[ai][bj][m][1][e]; }
#pragma unroll
                    for (int e = 0; e < 4; ++e) { v[2 * e] *= bf_lo(gw[e]); v[2 * e + 1] *= bf_hi(gw[e]); }
                    u16* tp = T + row * 2048 + col;
                    if (!first) { const u32x4 tw = *(const u32x4*)tp;
#pragma unroll
                        for (int e = 0; e < 4; ++e) { v[2 * e] += bf_lo(tw[e]); v[2 * e + 1] += bf_hi(tw[e]); } }
                    u32x4 o; o[0] = pk2(v[0], v[1]); o[1] = pk2(v[2], v[3]); o[2] = pk2(v[4], v[5]); o[3] = pk2(v[6], v[7]);
                    *(u32x4*)tp = o; } }
    }
};
struct EpiRes {
    static constexpr bool PERM = false, AFTER_DRAIN = false;
    float* O; const float* R; const float* mod; int goff; int row_off;
    __device__ __forceinline__ void operator()(const f32x4 (&acc)[2][2][4][2], const Unit& u, int wr, int wc, int fr, int fq) const {
        const int row0 = row_off + u.pm * BM + wr * 64 + fr, col0 = u.pn * BM + wc * 32 + 4 * fq;
        const int b = (row_off + u.pm * BM) / SEQ;
        f32x4 gv[2][2];
#pragma unroll
        for (int bj = 0; bj < 2; ++bj)
#pragma unroll
            for (int n = 0; n < 2; ++n) gv[bj][n] = *(const f32x4*)(mod + (size_t)b * NMOD + goff + col0 + bj * HALF + n * 16);
#pragma unroll
        for (int ai = 0; ai < 2; ++ai)
#pragma unroll
            for (int m = 0; m < 4; ++m) { const size_t ro = (size_t)(row0 + ai * HALF + m * 16) * 2048 + col0;
#pragma unroll
                for (int bj = 0; bj < 2; ++bj)
#pragma unroll
                    for (int n = 0; n < 2; ++n) { const f32x4 r = *(const f32x4*)(R + ro + bj * HALF + n * 16);
                        *(f32x4*)(O + ro + bj * HALF + n * 16) = r + gv[bj][n] * acc[ai][bj][m][n]; } }
    }
};
struct EpiResB {
    static constexpr bool PERM = true, AFTER_DRAIN = false;
    u16* O; const float* R; const float* mod; int goff;
    __device__ __forceinline__ void operator()(const f32x4 (&acc)[2][2][4][2], const Unit& u, int wr, int wc, int fr, int fq) const {
        const int row0 = u.pm * BM + wr * 64 + fr, col0 = u.pn * BM + wc * 32 + 8 * fq;
        const int b = (u.pm * BM) / SEQ;
        f32x4 gv[2][2];
#pragma unroll
        for (int bj = 0; bj < 2; ++bj)
#pragma unroll
            for (int n = 0; n < 2; ++n) gv[bj][n] = *(const f32x4*)(mod + (size_t)b * NMOD + goff + col0 + bj * HALF + n * 4);
#pragma unroll
        for (int ai = 0; ai < 2; ++ai)
#pragma unroll
            for (int m = 0; m < 4; ++m) { const size_t ro = (size_t)(row0 + ai * HALF + m * 16) * 2048 + col0;
#pragma unroll
                for (int bj = 0; bj < 2; ++bj) {
                    const f32x4 r0 = __builtin_nontemporal_load((const f32x4*)(R + ro + bj * HALF)), r1 = __builtin_nontemporal_load((const f32x4*)(R + ro + bj * HALF + 4));
                    const f32x4 v0 = r0 + gv[bj][0] * acc[ai][bj][m][0], v1 = r1 + gv[bj][1] * acc[ai][bj][m][1];
                    u32x4 o; o[0] = pk2(v0[0], v0[1]); o[1] = pk2(v0[2], v0[3]); o[2] = pk2(v1[0], v1[1]); o[3] = pk2(v1[2], v1[3]);
                    *(u32x4*)(O + ro + bj * HALF) = o; } }
    }
};
struct EpiOut {
    static constexpr bool PERM = true, AFTER_DRAIN = false;
    float* O; const u16* R; const float* mod; int goff;
    __device__ __forceinline__ void operator()(const f32x4 (&acc)[2][2][4][2], const Unit& u, int wr, int wc, int fr, int fq) const {
        const int row0 = u.pm * BM + wr * 64 + fr, col0 = u.pn * BM + wc * 32 + 8 * fq;
        const int b = (u.pm * BM) / SEQ;
        f32x4 gv[2][2];
#pragma unroll
        for (int bj = 0; bj < 2; ++bj)
#pragma unroll
            for (int n = 0; n < 2; ++n) gv[bj][n] = *(const f32x4*)(mod + (size_t)b * NMOD + goff + col0 + bj * HALF + n * 4);
#pragma unroll
        for (int ai = 0; ai < 2; ++ai)
#pragma unroll
            for (int m = 0; m < 4; ++m) { const size_t ro = (size_t)(row0 + ai * HALF + m * 16) * 2048 + col0;
#pragma unroll
                for (int bj = 0; bj < 2; ++bj) {
                    const u32x4 rw = *(const u32x4*)(R + ro + bj * HALF);
                    const f32x4 r0 = (f32x4){bf_lo(rw[0]), bf_hi(rw[0]), bf_lo(rw[1]), bf_hi(rw[1])}, r1 = (f32x4){bf_lo(rw[2]), bf_hi(rw[2]), bf_lo(rw[3]), bf_hi(rw[3])};
                    *(f32x4*)(O + ro + bj * HALF) = r0 + gv[bj][0] * acc[ai][bj][m][0];
                    *(f32x4*)(O + ro + bj * HALF + 4) = r1 + gv[bj][1] * acc[ai][bj][m][1]; } }
    }
};
struct EpiRaw {
    static constexpr bool PERM = true, AFTER_DRAIN = false;
    u16* O; int ldc;
    __device__ __forceinline__ void operator()(const f32x4 (&acc)[2][2][4][2], const Unit& u, int wr, int wc, int fr, int fq) const {
        const int row0 = u.pm * BM + wr * 64 + fr, col0 = u.pn * BM + wc * 32 + 8 * fq;
#pragma unroll
        for (int ai = 0; ai < 2; ++ai)
#pragma unroll
            for (int m = 0; m < 4; ++m) { u16* rowp = O + (size_t)(row0 + ai * HALF + m * 16) * ldc + col0;
#pragma unroll
                for (int bj = 0; bj < 2; ++bj) { const f32x4 v0 = acc[ai][bj][m][0], v1 = acc[ai][bj][m][1];
                    u32x4 o; o[0] = pk2(v0[0], v0[1]); o[1] = pk2(v0[2], v0[3]); o[2] = pk2(v1[0], v1[1]); o[3] = pk2(v1[2], v1[3]);
                    *(u32x4*)(rowp + bj * HALF) = o; } }
    }
};
DI float dpp_ror1(float v) { return __int_as_float(__builtin_amdgcn_mov_dpp(__float_as_int(v), 0x121, 0xF, 0xF, true)); }
DI float dpp_ror2(float v) { return __int_as_float(__builtin_amdgcn_mov_dpp(__float_as_int(v), 0x122, 0xF, 0xF, true)); }
struct EpiConv {
    static constexpr bool PERM = true, AFTER_DRAIN = false;
    u16* act; u16* halo; const float* cw; const float* cb;
    __device__ __forceinline__ void operator()(const f32x4 (&acc)[2][2][4][2], const Unit& u, int wr, int wc, int fr, int fq) const {
        const int col0 = u.pn * 128 + wc * 32 + 8 * fq;
#pragma unroll
        for (int n = 0; n < 2; ++n) {
            const int cbase = col0 + 4 * n;
            const f32x4 wa0 = *(const f32x4*)(cw + cbase), wa1 = *(const f32x4*)(cw + NUP + cbase), wa2 = *(const f32x4*)(cw + 2 * NUP + cbase), ba = *(const f32x4*)(cb + cbase);
            const f32x4 wb0 = *(const f32x4*)(cw + DFF + cbase), wb1 = *(const f32x4*)(cw + NUP + DFF + cbase), wb2 = *(const f32x4*)(cw + 2 * NUP + DFF + cbase), bb = *(const f32x4*)(cb + DFF + cbase);
#pragma unroll
            for (int ai = 0; ai < 2; ++ai) {
                const int rowb = u.pm * BM + ai * HALF + wr * 64;
                const int q = rowb >> 6;
                f32x4 pa1 = (f32x4){0.f, 0.f, 0.f, 0.f}, pa2 = pa1, pb1 = pa1, pb2 = pa1;
#pragma unroll
                for (int m = 0; m < 4; ++m) {
                    const f32x4 xa = acc[ai][0][m][n], xb = acc[ai][1][m][n];
                    f32x4 ca1, ca2, cb1, cb2, res;
#pragma unroll
                    for (int e = 0; e < 4; ++e) { ca1[e] = dpp_ror1(xa[e]); ca2[e] = dpp_ror2(xa[e]); cb1[e] = dpp_ror1(xb[e]); cb2[e] = dpp_ror2(xb[e]); }
#pragma unroll
                    for (int e = 0; e < 4; ++e) {
                        const float a1 = (fr == 0) ? pa1[e] : ca1[e], a2 = (fr < 2) ? pa2[e] : ca2[e];
                        const float b1 = (fr == 0) ? pb1[e] : cb1[e], b2 = (fr < 2) ? pb2[e] : cb2[e];
                        const float ya = ba[e] + wa0[e] * a2 + wa1[e] * a1 + wa2[e] * xa[e];
                        const float yb = bb[e] + wb0[e] * b2 + wb1[e] * b1 + wb2[e] * xb[e];
                        res[e] = silu_f(ya) * yb;
                    }
                    u32x2 o; o[0] = pk2(res[0], res[1]); o[1] = pk2(res[2], res[3]);
                    *(u32x2*)(act + (size_t)(rowb + m * 16 + fr) * DFF + cbase) = o;
                    if (m == 0 && fr < 2) {
                        u16* hp = halo + ((size_t)q * 4 + 2 + fr) * NUP + cbase;
                        u32x2 ha, hb2; ha[0] = pk2(xa[0], xa[1]); ha[1] = pk2(xa[2], xa[3]); hb2[0] = pk2(xb[0], xb[1]); hb2[1] = pk2(xb[2], xb[3]);
                        *(u32x2*)hp = ha; *(u32x2*)(hp + DFF) = hb2;
                    }
                    if (m == 3 && fr >= 14) {
                        u16* hp = halo + ((size_t)(q + 1) * 4 + (fr - 14)) * NUP + cbase;
                        u32x2 ha, hb2; ha[0] = pk2(xa[0], xa[1]); ha[1] = pk2(xa[2], xa[3]); hb2[0] = pk2(xb[0], xb[1]); hb2[1] = pk2(xb[2], xb[3]);
                        *(u32x2*)hp = ha; *(u32x2*)(hp + DFF) = hb2;
                    }
                    pa1 = ca1; pa2 = ca2; pb1 = cb1; pb2 = cb2;
                }
            }
        }
    }
};
template <class Epi> DI void run_gemm(unsigned char* lds, const u16* A, const u16* Bt, int M, int N, int K, const Epi& E, int cid) {
    pg8::Gemm g; g.A = A; g.Bt = Bt; g.M = M; g.N = N; g.K = K;
    pg8::StaticOrder S; S.init(M, N, (int)gridDim.x, cid); S.wgm = (N > 2048) ? WGM_WIDE : WGM_NARROW;
    pg8::gemm_phase<Epi, pg8::StaticOrder, false>((PG8_LAS unsigned char*)lds, g, S, E, nullptr);
    __syncthreads();
}

DI void mixer_a_phase(const Args& a, const WS& w, unsigned char* lds) {
    const int lane = threadIdx.x & 63, wave = __builtin_amdgcn_readfirstlane(threadIdx.x >> 6), fr = lane & 15, fq = lane >> 4;
    float* rstd_s = (float*)lds;
    u16* VT = (u16*)(lds + 1024) + wave * (32 * 136);
    for (int item = blockIdx.x; item < 256; item += gridDim.x) {
        const int t0 = item * 128;
        __syncthreads();
#pragma unroll 1
        for (int rb = 0; rb < 2; ++rb) {
            u32x4 x0[8], x1[8];
#pragma unroll
            for (int r = 0; r < 8; ++r) { const u16* rp = w.proj + (size_t)(t0 + wave * 16 + rb * 8 + r) * NP + C_VA;
                x0[r] = *(const u32x4*)(rp + lane * 8); x1[r] = *(const u32x4*)(rp + 512 + lane * 8); }
#pragma unroll
            for (int r = 0; r < 8; ++r) {
                float ss = 0.f;
#pragma unroll
                for (int e = 0; e < 4; ++e) { float p = bf_lo(x0[r][e]), q = bf_hi(x0[r][e]), r2 = bf_lo(x1[r][e]), s2 = bf_hi(x1[r][e]); ss += p * p + q * q + r2 * r2 + s2 * s2; }
#pragma unroll
                for (int o = 32; o >= 1; o >>= 1) ss += __shfl_xor(ss, o);
                if (lane == 0) rstd_s[wave * 16 + rb * 8 + r] = rsqrtf(ss * (1.0f / 1024.0f) + EPSN);
            }
        }
        __syncthreads();
        const int g = wave;
        bf16x8 Wf[20];
        {
            int idx = 0;
#pragma unroll
            for (int tt = 0; tt < 8; ++tt) {
                const int t = tt * 16 + fr;
                const float* wrow = a.w_spatial + ((size_t)g * 128 + t) * 128;
#pragma unroll
                for (int sc = 0; sc <= (tt >> 1); ++sc) {
                    const int sb = sc * 32 + 8 * fq;
                    const f32x4 a0 = *(const f32x4*)(wrow + sb), a1 = *(const f32x4*)(wrow + sb + 4);
                    float av[8];
#pragma unroll
                    for (int e = 0; e < 4; ++e) { av[e] = (sb + e <= t) ? a0[e] : 0.f; av[4 + e] = (sb + 4 + e <= t) ? a1[e] : 0.f; }
                    u32x4 ap; ap[0] = pk2(av[0], av[1]); ap[1] = pk2(av[2], av[3]); ap[2] = pk2(av[4], av[5]); ap[3] = pk2(av[6], av[7]);
                    Wf[idx++] = __builtin_bit_cast(bf16x8, ap);
                }
            }
        }
#pragma unroll 1
        for (int ch = 0; ch < 4; ++ch) {
            const int cbase = g * 128 + ch * 32;
            __syncthreads();
            {
                u32x4 raw[8];
#pragma unroll
                for (int i = 0; i < 8; ++i) { const int idx = lane + 64 * i, s = idx >> 2, cq = idx & 3;
                    raw[i] = *(const u32x4*)(w.proj + (size_t)(t0 + s) * NP + C_VA + cbase + cq * 8); }
                const int cq = lane & 3;
                const f32x4 vg0 = *(const f32x4*)(a.v_norm_g + cbase + cq * 8), vg1 = *(const f32x4*)(a.v_norm_g + cbase + cq * 8 + 4);
#pragma unroll
                for (int i = 0; i < 8; ++i) { const int s = (lane + 64 * i) >> 2; const float rs = rstd_s[s];
                    u16* vp = VT + (cq * 8) * 136 + s;
                    vp[0 * 136] = (u16)(pk2(bf_lo(raw[i][0]) * rs * vg0[0], 0.f) & 0xffffu); vp[1 * 136] = (u16)(pk2(bf_hi(raw[i][0]) * rs * vg0[1], 0.f) & 0xffffu);
                    vp[2 * 136] = (u16)(pk2(bf_lo(raw[i][1]) * rs * vg0[2], 0.f) & 0xffffu); vp[3 * 136] = (u16)(pk2(bf_hi(raw[i][1]) * rs * vg0[3], 0.f) & 0xffffu);
                    vp[4 * 136] = (u16)(pk2(bf_lo(raw[i][2]) * rs * vg1[0], 0.f) & 0xffffu); vp[5 * 136] = (u16)(pk2(bf_hi(raw[i][2]) * rs * vg1[1], 0.f) & 0xffffu);
                    vp[6 * 136] = (u16)(pk2(bf_lo(raw[i][3]) * rs * vg1[2], 0.f) & 0xffffu); vp[7 * 136] = (u16)(pk2(bf_hi(raw[i][3]) * rs * vg1[3], 0.f) & 0xffffu); }
            }
            __syncthreads();
            u32x2 uu[8][2];
#pragma unroll
            for (int tt = 0; tt < 8; ++tt) { const size_t tok = (size_t)(t0 + tt * 16 + fr);
                uu[tt][0] = *(const u32x2*)(w.proj + tok * NP + C_U + cbase + 4 * fq); uu[tt][1] = *(const u32x2*)(w.proj + tok * NP + C_U + cbase + 16 + 4 * fq); }
            {
                int idx = 0;
#pragma unroll
                for (int tt = 0; tt < 8; ++tt) {
                    f32x4 acc0 = (f32x4){0.f, 0.f, 0.f, 0.f}, acc1 = acc0;
                    const int t = tt * 16 + fr;
                    const size_t tok = (size_t)(t0 + t);
                    const float bs = a.b_spatial[g * 128 + t];
#pragma unroll
                    for (int sc = 0; sc <= (tt >> 1); ++sc) {
                        const int sb = sc * 32 + 8 * fq;
                        const bf16x8 B0 = *(const bf16x8*)(VT + fr * 136 + sb), B1 = *(const bf16x8*)(VT + (16 + fr) * 136 + sb);
                        acc0 = __builtin_amdgcn_mfma_f32_16x16x32_bf16(B0, Wf[idx], acc0, 0, 0, 0);
                        acc1 = __builtin_amdgcn_mfma_f32_16x16x32_bf16(B1, Wf[idx], acc1, 0, 0, 0);
                        ++idx;
                    }
                    const u32x2 u0 = uu[tt][0], u1 = uu[tt][1];
                    u32x2 o0, o1;
                    o0[0] = pk2(bf_lo(u0[0]) * (acc0[0] + bs), bf_hi(u0[0]) * (acc0[1] + bs)); o0[1] = pk2(bf_lo(u0[1]) * (acc0[2] + bs), bf_hi(u0[1]) * (acc0[3] + bs));
                    o1[0] = pk2(bf_lo(u1[0]) * (acc1[0] + bs), bf_hi(u1[0]) * (acc1[1] + bs)); o1[1] = pk2(bf_lo(u1[1]) * (acc1[2] + bs), bf_hi(u1[1]) * (acc1[3] + bs));
                    *(u32x2*)(w.ya + tok * 1024 + cbase + 4 * fq) = o0;
                    *(u32x2*)(w.ya + tok * 1024 + cbase + 16 + 4 * fq) = o1;
                }
            }
        }
    }
    __syncthreads();
}

DI void kv_prep_phase(const Args& a, const WS& w, unsigned char* lds) {
    const int lane = threadIdx.x & 63, wave = __builtin_amdgcn_readfirstlane(threadIdx.x >> 6);
    const int gw = blockIdx.x * 8 + wave, nw = gridDim.x * 8;
    const f32x4 kg = *(const f32x4*)(a.k_norm_g + (lane & 31) * 4);
    for (int t0 = gw; t0 < NTOK; t0 += 4 * nw) {
        u32x2 kv4[4];
#pragma unroll
        for (int q = 0; q < 4; ++q) { const int t = t0 + q * nw; kv4[q] = (t < NTOK) ? *(const u32x2*)(w.proj + (size_t)t * NP + C_K + lane * 4) : (u32x2){0u, 0u}; }
#pragma unroll
        for (int q = 0; q < 4; ++q) {
            const int t = t0 + q * nw;
            const u32x2 kv = kv4[q];
            const float v0 = bf_lo(kv[0]), v1 = bf_hi(kv[0]), v2 = bf_lo(kv[1]), v3 = bf_hi(kv[1]);
            float ss = v0 * v0 + v1 * v1 + v2 * v2 + v3 * v3;
#pragma unroll
            for (int o = 16; o >= 1; o >>= 1) ss += __shfl_xor(ss, o);
            const float rstd = rsqrtf(ss * (1.0f / 128.0f) + EPSN);
            u32x2 o; o[0] = pk2(v0 * rstd * kg[0], v1 * rstd * kg[1]); o[1] = pk2(v2 * rstd * kg[2], v3 * rstd * kg[3]);
            if (t < NTOK) *(u32x2*)(w.kn + (size_t)t * 256 + lane * 4) = o;
        }
    }
    u16* tile = (u16*)lds;
    const int tid = threadIdx.x;
    for (int item0 = blockIdx.x; item0 < NB * 32 * 4; item0 += 4 * gridDim.x) {
        __syncthreads();
        u32x4 ld[4];
#pragma unroll
        for (int q = 0; q < 4; ++q) { const int item = item0 + q * gridDim.x;
            if (item < NB * 32 * 4) { const int b = item >> 7, st = (item >> 2) & 31, dt = item & 3; const int sr = tid >> 3, dc = (tid & 7) * 8;
                ld[q] = *(const u32x4*)(w.proj + (size_t)(b * SEQ + st * 64 + sr) * NP + C_VB + dt * 64 + dc); } }
#pragma unroll
        for (int q = 0; q < 4; ++q) { const int item = item0 + q * gridDim.x;
            if (item < NB * 32 * 4) { const int sr = tid >> 3, dc = (tid & 7) * 8; *(u32x4*)(tile + q * 4608 + sr * 72 + dc) = ld[q]; } }
        __syncthreads();
#pragma unroll
        for (int q = 0; q < 4; ++q) { const int item = item0 + q * gridDim.x;
            if (item < NB * 32 * 4) { const int b = item >> 7, st = (item >> 2) & 31, dt = item & 3; const int dr = tid >> 3, sc8 = (tid & 7) * 8; u32x4 o;
#pragma unroll
                for (int e = 0; e < 4; ++e) o[e] = (u32)tile[q * 4608 + (sc8 + 2 * e) * 72 + dr] | ((u32)tile[q * 4608 + (sc8 + 2 * e + 1) * 72 + dr] << 16);
                *(u32x4*)(w.vt + ((size_t)b * 256 + dt * 64 + dr) * SEQ + st * 64 + sc8) = o; } }
    }
    __syncthreads();
}
#define MFMA32(a, b, c) __builtin_amdgcn_mfma_f32_32x32x16_bf16((a), (b), (c), 0, 0, 0)
DI float xhalf_add(float a, float b) {
    const auto r = __builtin_amdgcn_permlane32_swap(__float_as_uint(a), __float_as_uint(b), false, false);
    return __uint_as_float(r[0]) + __uint_as_float(r[1]);
}
DI float xhalf_max(float a) {
    const auto r = __builtin_amdgcn_permlane32_swap(__float_as_uint(a), __float_as_uint(a), false, false);
    return fmaxf(__uint_as_float(r[0]), __uint_as_float(r[1]));
}
DI int half_sum_dpp(int v) {
    v += __builtin_amdgcn_update_dpp(0, v, 0xB1, 0xF, 0xF, false);
    v += __builtin_amdgcn_update_dpp(0, v, 0x4E, 0xF, 0xF, false);
    v += __builtin_amdgcn_update_dpp(0, v, 0x141, 0xF, 0xF, false);
    v += __builtin_amdgcn_update_dpp(0, v, 0x140, 0xF, 0xF, false);
    v += __builtin_amdgcn_update_dpp(0, v, 0x142, 0xA, 0xF, false);
    return v;
}
constexpr int IX_SC = 131072, IX_STG = 8192;
DI void indexer_phase(const Args& a, const WS& w, unsigned char* lds) {
    const int tid = threadIdx.x, lane = tid & 63, wave = __builtin_amdgcn_readfirstlane(tid >> 6), hb = lane >> 5, l32 = lane & 31;
    float* scl = (float*)(lds + wave * 16384);
    PG8_LAS unsigned char* stg = (PG8_LAS unsigned char*)lds + IX_SC + wave * 1024;
    const unsigned char* stgr = lds + IX_SC;
    const int prow = tid >> 3, ppos = tid & 7;
    const u32 soff = (u32)prow * (u32)(NP * 2) + (u32)((ppos ^ ((prow >> 1) & 7)) * 16);
    const int bfo = l32 * 128, bx = (l32 >> 1) & 7;
    const float idx_scale = 0.125f * 0.25f;
    int r = 0;
    bf16x8 Afn[4]; u32x2 wrn[4];
#define IX_LOAD_ITEM(itv, rv) do { const int _b = (itv) >> 7; int _ib = (itv) & 127; if ((rv) & 1) _ib = 127 - _ib; const int _t0 = _b * SEQ + _ib * 16 + 2 * wave; \
        const u16* _qp = w.proj + (size_t)(_t0 + (l32 >> 4)) * NP + C_QI + (l32 & 15) * 64 + 8 * hb; \
        _Pragma("unroll") for (int kk = 0; kk < 4; ++kk) Afn[kk] = *(const bf16x8*)(_qp + 16 * kk); \
        const u16* _wp = w.proj + (size_t)_t0 * NP + C_WI + 4 * hb; \
        wrn[0] = *(const u32x2*)_wp; wrn[1] = *(const u32x2*)(_wp + 8); wrn[2] = *(const u32x2*)(_wp + NP); wrn[3] = *(const u32x2*)(_wp + NP + 8); } while (0)
    if ((int)blockIdx.x < NTOK / 16) IX_LOAD_ITEM((int)blockIdx.x, 0);
    for (int it0 = blockIdx.x; it0 < NTOK / 16; it0 += gridDim.x, ++r) {
        const int b = it0 >> 7; int ib = it0 & 127; if (r & 1) ib = 127 - ib;
        const int p0 = ib * 16 + 2 * wave, t0 = b * SEQ + p0;
        const int jmax = ib >> 1, nst = (jmax >> 1) + 1;
        const char* kbase = (const char*)(w.proj + (size_t)b * SEQ * NP + C_KI);
#define IX_STAGE(stage) __builtin_amdgcn_global_load_lds((const unsigned*)(kbase + (size_t)(stage) * 64 * (NP * 2) + soff), (PG8_LAS unsigned*)(stg + ((stage) % 3) * IX_STG), 16, 0, 0)
        bf16x8 Af[4];
#pragma unroll
        for (int kk = 0; kk < 4; ++kk) Af[kk] = Afn[kk];
        float wv0[8], wv1[8];
        wv0[0] = bf_lo(wrn[0][0]) * idx_scale; wv0[1] = bf_hi(wrn[0][0]) * idx_scale; wv0[2] = bf_lo(wrn[0][1]) * idx_scale; wv0[3] = bf_hi(wrn[0][1]) * idx_scale;
        wv0[4] = bf_lo(wrn[1][0]) * idx_scale; wv0[5] = bf_hi(wrn[1][0]) * idx_scale; wv0[6] = bf_lo(wrn[1][1]) * idx_scale; wv0[7] = bf_hi(wrn[1][1]) * idx_scale;
        wv1[0] = bf_lo(wrn[2][0]) * idx_scale; wv1[1] = bf_hi(wrn[2][0]) * idx_scale; wv1[2] = bf_lo(wrn[2][1]) * idx_scale; wv1[3] = bf_hi(wrn[2][1]) * idx_scale;
        wv1[4] = bf_lo(wrn[3][0]) * idx_scale; wv1[5] = bf_hi(wrn[3][0]) * idx_scale; wv1[6] = bf_lo(wrn[3][1]) * idx_scale; wv1[7] = bf_hi(wrn[3][1]) * idx_scale;
        asm volatile("s_waitcnt vmcnt(0)" ::: "memory");
        __builtin_amdgcn_s_barrier();
        asm volatile("" ::: "memory");
        IX_STAGE(0);
        if (nst > 1) IX_STAGE(1);
        for (int st = 0; st < nst; ++st) {
            if (st + 1 < nst) asm volatile("s_waitcnt vmcnt(1)" ::: "memory"); else asm volatile("s_waitcnt vmcnt(0)" ::: "memory");
            __builtin_amdgcn_s_barrier();
            asm volatile("" ::: "memory");
            if (st + 2 < nst) IX_STAGE(st + 2);
            const unsigned char* sb = stgr + (st % 3) * IX_STG + bfo;
#define IX_SUB(sub) { const int j = 2 * st + (sub); \
                f32x16 cacc; \
                _Pragma("unroll") for (int i = 0; i < 16; ++i) cacc[i] = 0.f; \
                _Pragma("unroll") for (int kk = 0; kk < 4; ++kk) cacc = MFMA32(Af[kk], *(const bf16x8*)(sb + (sub) * 4096 + (((2 * kk + hb) ^ bx) << 4)), cacc); \
                float s0 = 0.f, s1 = 0.f; \
                _Pragma("unroll") for (int i = 0; i < 8; ++i) { s0 += wv0[i] * fmaxf(cacc[i], 0.f); s1 += wv1[i] * fmaxf(cacc[8 + i], 0.f); } \
                const float mine = xhalf_add(s0, s1); \
                scl[hb * 2048 + j * 32 + l32] = mine; }
            if (2 * st + 1 <= jmax) { IX_SUB(0) IX_SUB(1) } else { IX_SUB(0) }
        }
        asm volatile("s_waitcnt lgkmcnt(0)" ::: "memory");
        if (it0 + (int)gridDim.x < NTOK / 16) IX_LOAD_ITEM(it0 + (int)gridDim.x, r + 1);
        const int pl = p0 + hb;
        u32 uk[64];
#pragma unroll
        for (int j = 0; j < 64; ++j) {
            const int key = j * 32 + l32;
            const u32 u = __float_as_uint(scl[hb * 2048 + key]);
            const u32 s = u ^ (u32)(((int)u >> 31) | (int)0x80000000);
            uk[j] = (key <= pl) ? s : 0u;
            __builtin_amdgcn_sched_barrier(0);
        }
        asm volatile("s_waitcnt lgkmcnt(0)" ::: "memory");
        u32 T0 = 0u, T1 = 0u; bool done0 = (p0 + 1 <= 256), done1 = (p0 + 2 <= 256);
        if (done0) T0 = 1u; if (done1) T1 = 1u;
        for (int bit = 31; bit >= 0; --bit) {
            if (done0 && done1) break;
            const u32 c0 = T0 | (1u << bit), c1 = T1 | (1u << bit);
            const u32 cv = hb ? c1 : c0;
            int cnt = 0;
#pragma unroll
            for (int j = 0; j < 16; ++j) cnt += (uk[j] >= cv) ? 1 : 0;
            if (jmax >= 16) {
#pragma unroll
                for (int j = 16; j < 32; ++j) cnt += (uk[j] >= cv) ? 1 : 0;
            }
            if (jmax >= 32) {
#pragma unroll
                for (int j = 32; j < 48; ++j) cnt += (uk[j] >= cv) ? 1 : 0;
            }
            if (jmax >= 48) {
#pragma unroll
                for (int j = 48; j < 64; ++j) cnt += (uk[j] >= cv) ? 1 : 0;
            }
            cnt = half_sum_dpp(cnt);
            const int n0 = __builtin_amdgcn_readlane(cnt, 31), n1 = __builtin_amdgcn_readlane(cnt, 63);
            if (!done0) { if (n0 >= 256) T0 = c0; if (n0 == 256) done0 = true; }
            if (!done1) { if (n1 >= 256) T1 = c1; if (n1 == 256) done1 = true; }
        }
        const u32 Tv = hb ? T1 : T0;
        int gcnt = 0;
#pragma unroll
        for (int j = 0; j < 64; ++j) gcnt += (uk[j] > Tv) ? 1 : 0;
        gcnt = half_sum_dpp(gcnt);
        const int g0 = __builtin_amdgcn_readlane(gcnt, 31), g1 = __builtin_amdgcn_readlane(gcnt, 63);
        u32 w0 = 0u, w1 = 0u;
        int lz = lane; asm volatile("" : "+v"(lz));
        if (done0 && done1) {
#pragma unroll
            for (int j = 0; j < 64; ++j) {
                const unsigned long long bs = __ballot(uk[j] >= Tv);
                w0 = (lz == j) ? (u32)bs : w0; w1 = (lz == j) ? (u32)(bs >> 32) : w1;
                __builtin_amdgcn_sched_barrier(0);
            }
        } else {
            const int need0 = done0 ? 0x7fffffff : 256 - g0, need1 = done1 ? 0x7fffffff : 256 - g1;
            const int need = hb ? need1 : need0;
            int run0 = 0, run1 = 0;
            const u32 ltmask = (1u << l32) - 1u;
#pragma unroll
            for (int j = 0; j < 64; ++j) {
                const bool eq = (uk[j] == Tv);
                const unsigned long long be = __ballot(eq);
                const u32 mybe = hb ? (u32)(be >> 32) : (u32)be;
                const int rank = (hb ? run1 : run0) + __popc(mybe & ltmask);
                const bool sel = (uk[j] > Tv) || (eq && rank < need);
                run0 += __popc((u32)be); run1 += __popc((u32)(be >> 32));
                const unsigned long long bs = __ballot(sel);
                w0 = (lz == j) ? (u32)bs : w0; w1 = (lz == j) ? (u32)(bs >> 32) : w1;
                __builtin_amdgcn_sched_barrier(0);
            }
        }
        w.mask[(size_t)t0 * 64 + lane] = w0; w.mask[(size_t)(t0 + 1) * 64 + lane] = w1;
    }
    __syncthreads();
}

constexpr int AT_KROW = 256, AT_VROW = 128, AT_KBYTES = 64 * AT_KROW, AT_STAGE = AT_KBYTES + 128 * AT_VROW;
DI void attn_item(const Args& a, const WS& w, unsigned char* lds, int b, int g, int qb) {
    const int tid = threadIdx.x, lane = tid & 63, wave = __builtin_amdgcn_readfirstlane(tid >> 6), hb = lane >> 5, l32 = lane & 31;
    const int h = 4 * g + (wave & 3), qsub = wave >> 2, q0 = qb * 64 + qsub * 32;
    const size_t tq = (size_t)b * SEQ + q0 + l32;
    bf16x8 qf[8]; float nq2 = 0.f;
    { const u16* qp = w.proj + tq * NP + C_Q + h * 128 + 8 * hb;
      float ss = 0.f;
#pragma unroll
      for (int kk = 0; kk < 8; ++kk) { const u32x4 raw = *(const u32x4*)(qp + 16 * kk);
#pragma unroll
          for (int e = 0; e < 4; ++e) { const float lo = bf_lo(raw[e]), hi = bf_hi(raw[e]); ss += lo * lo + hi * hi; } }
      ss += __shfl_xor(ss, 32);
      const float sc = rsqrtf(ss * (1.0f / 128.0f) + EPSN) * 0.08838834764831845f * 1.44269504089f;
#pragma unroll
      for (int kk = 0; kk < 8; ++kk) { const u32x4 raw = *(const u32x4*)(qp + 16 * kk);
          const f32x4 g0 = *(const f32x4*)(a.q_norm_g + 16 * kk + 8 * hb), g1 = *(const f32x4*)(a.q_norm_g + 16 * kk + 8 * hb + 4);
          u32x4 o;
          o[0] = pk2(bf_lo(raw[0]) * sc * g0[0], bf_hi(raw[0]) * sc * g0[1]); o[1] = pk2(bf_lo(raw[1]) * sc * g0[2], bf_hi(raw[1]) * sc * g0[3]);
          o[2] = pk2(bf_lo(raw[2]) * sc * g1[0], bf_hi(raw[2]) * sc * g1[1]); o[3] = pk2(bf_lo(raw[3]) * sc * g1[2], bf_hi(raw[3]) * sc * g1[3]);
          qf[kk] = __builtin_bit_cast(bf16x8, o);
#pragma unroll
          for (int e = 0; e < 4; ++e) { const float lo = bf_lo(o[e]), hi = bf_hi(o[e]); nq2 += lo * lo + hi * hi; }
          __builtin_amdgcn_sched_barrier(0); } }
    float mfix;
    { float gm = fmaxf(fabsf(a.k_norm_g[lane]), fabsf(a.k_norm_g[lane + 64]));
#pragma unroll
      for (int o = 32; o >= 1; o >>= 1) gm = fmaxf(gm, __shfl_xor(gm, o));
      const float nq = xhalf_add(nq2, nq2);
      mfix = sqrtf(nq) * 11.3137085f * gm * 1.004f; }
    f32x16 o[4];
#pragma unroll
    for (int d = 0; d < 4; ++d)
#pragma unroll
        for (int i = 0; i < 16; ++i) o[d][i] = 0.f;
    float lsum = 0.f;
    const int rperm = (l32 & 0x13) | ((l32 & 4) << 1) | ((l32 & 8) >> 1);
    const int p0 = tid, p1 = tid + 512;
    const char* kbase = (const char*)(w.kn + (size_t)b * SEQ * 256 + g * 128);
    const char* vbase = (const char*)(w.vt + ((size_t)b * 256 + g * 128) * SEQ);
    const u32 ko0 = (u32)(((p0 >> 4) * 256 + (((p0 & 15) ^ ((p0 >> 4) & 15)) * 8)) * 2), ko1 = (u32)(((p1 >> 4) * 256 + (((p1 & 15) ^ ((p1 >> 4) & 15)) * 8)) * 2);
    const u32 vo0 = (u32)(((p0 >> 3) * SEQ + (((p0 & 7) ^ ((p0 >> 4) & 7)) * 8)) * 2), vo1 = (u32)(((p1 >> 3) * SEQ + (((p1 & 7) ^ ((p1 >> 4) & 7)) * 8)) * 2);
    PG8_LAS unsigned char* ldsw = (PG8_LAS unsigned char*)lds + wave * 1024;
#define AT_STAGE_TILE(bufo, ktile) do { const char* _kb = kbase + (size_t)(ktile) * 64 * 512; const char* _vb = vbase + (size_t)(ktile) * 128; \
        __builtin_amdgcn_global_load_lds((const unsigned*)(_kb + ko0), (PG8_LAS unsigned*)(ldsw + (bufo)), 16, 0, 0); \
        __builtin_amdgcn_global_load_lds((const unsigned*)(_kb + ko1), (PG8_LAS unsigned*)(ldsw + (bufo) + 8192), 16, 0, 0); \
        __builtin_amdgcn_global_load_lds((const unsigned*)(_vb + vo0), (PG8_LAS unsigned*)(ldsw + (bufo) + AT_KBYTES), 16, 0, 0); \
        __builtin_amdgcn_global_load_lds((const unsigned*)(_vb + vo1), (PG8_LAS unsigned*)(ldsw + (bufo) + AT_KBYTES + 8192), 16, 0, 0); } while (0)
    const u32* mp = w.mask + tq * 64;
    const int r15 = rperm & 15, kfo = rperm * AT_KROW, vx = (l32 >> 1) & 7, vfo = AT_KBYTES + l32 * AT_VROW;
    u32x2 mwn = *(const u32x2*)mp;
    AT_STAGE_TILE(0, 0);
    if (qb >= 1) { AT_STAGE_TILE(AT_STAGE, 1); asm volatile("s_waitcnt vmcnt(4)" ::: "memory"); } else { asm volatile("s_waitcnt vmcnt(0)" ::: "memory"); }
    __builtin_amdgcn_s_barrier();
    asm volatile("" ::: "memory");
    for (int kt = 0; kt <= qb; ++kt) {
        const unsigned char* buf = lds + (kt % 3) * AT_STAGE;
        const u32x2 mwc = mwn;
        if (kt < qb) mwn = *(const u32x2*)(mp + 2 * (kt + 1));
        if (kt + 2 <= qb) { AT_STAGE_TILE(((kt + 2) % 3) * AT_STAGE, kt + 2); }
        const bool two = !(kt == qb && qsub == 0);
        const unsigned char* kb = buf + kfo;
        const unsigned char* vb = buf + vfo;
#define AT_QK(sv, sub) { _Pragma("unroll") for (int i = 0; i < 16; ++i) sv[i] = 0.f; \
            _Pragma("unroll") for (int kk = 0; kk < 8; ++kk) sv = MFMA32(*(const bf16x8*)(kb + (sub) * 32 * AT_KROW + (((2 * kk + hb) ^ r15) << 4)), qf[kk], sv); }
#define AT_SM(sv, pfv, sub) { const u32 mw0 = ((sub) ? mwc[1] : mwc[0]) >> (8 * hb); \
            _Pragma("unroll") for (int i = 0; i < 16; ++i) { const int bit = 16 * (i >> 3) + (i & 7); const float p = __builtin_amdgcn_exp2f(sv[i] - mfix); sv[i] = ((mw0 >> bit) & 1u) ? p : 0.f; lsum += sv[i]; if ((i & 3) == 3) __builtin_amdgcn_sched_barrier(0); } \
            _Pragma("unroll") for (int k2 = 0; k2 < 2; ++k2) { u32x4 pp; \
                _Pragma("unroll") for (int e = 0; e < 4; ++e) pp[e] = pk2(sv[8 * k2 + 2 * e], sv[8 * k2 + 2 * e + 1]); \
                pfv[k2] = __builtin_bit_cast(bf16x8, pp); } }
#define AT_PV(pfv, sub) { _Pragma("unroll") for (int d = 0; d < 4; ++d) \
                _Pragma("unroll") for (int k2 = 0; k2 < 2; ++k2) o[d] = MFMA32(*(const bf16x8*)(vb + d * 32 * AT_VROW + (((4 * (sub) + 2 * k2 + hb) ^ vx) << 4)), pfv[k2], o[d]); }
        const int nsub = two ? 2 : 1;
#pragma unroll 1
        for (int sub = 0; sub < nsub; ++sub) {
            f32x16 sa; bf16x8 pfa[2];
            _Pragma("unroll") for (int i = 0; i < 16; ++i) sa[i] = 0.f;
            _Pragma("unroll") for (int kk = 0; kk < 8; ++kk) sa = MFMA32(*(const bf16x8*)(kb + sub * 32 * AT_KROW + (((2 * kk + hb) ^ r15) << 4)), qf[kk], sa);
            const u32 mw0 = (sub ? mwc[1] : mwc[0]) >> (8 * hb);
            _Pragma("unroll") for (int i = 0; i < 16; ++i) { const int bit = 16 * (i >> 3) + (i & 7); const float p = __builtin_amdgcn_exp2f(sa[i] - mfix); sa[i] = ((mw0 >> bit) & 1u) ? p : 0.f; lsum += sa[i]; }
            _Pragma("unroll") for (int k2 = 0; k2 < 2; ++k2) { u32x4 pp;
                _Pragma("unroll") for (int e = 0; e < 4; ++e) pp[e] = pk2(sa[8 * k2 + 2 * e], sa[8 * k2 + 2 * e + 1]);
                pfa[k2] = __builtin_bit_cast(bf16x8, pp); }
            const int vsw = 4 * sub;
            _Pragma("unroll") for (int d = 0; d < 4; ++d)
                _Pragma("unroll") for (int k2 = 0; k2 < 2; ++k2) o[d] = MFMA32(*(const bf16x8*)(vb + d * 32 * AT_VROW + (((vsw + 2 * k2 + hb) ^ vx) << 4)), pfa[k2], o[d]);
        }
        if (kt + 2 <= qb) asm volatile("s_waitcnt vmcnt(4)" ::: "memory"); else asm volatile("s_waitcnt vmcnt(0)" ::: "memory");
        asm volatile("s_waitcnt lgkmcnt(0)" ::: "memory");
        __builtin_amdgcn_s_barrier();
        asm volatile("" ::: "memory");
    }
    lsum += __shfl_xor(lsum, 32);
    const float inv = 1.0f / lsum;
    u16* op = w.yb + tq * 1024 + h * 128 + 4 * hb;
#pragma unroll
    for (int d = 0; d < 4; ++d)
#pragma unroll
        for (int i4 = 0; i4 < 4; ++i4) { u32x2 ov; ov[0] = pk2(o[d][4 * i4] * inv, o[d][4 * i4 + 1] * inv); ov[1] = pk2(o[d][4 * i4 + 2] * inv, o[d][4 * i4 + 3] * inv);
            *(u32x2*)(op + 32 * d + 8 * i4) = ov; }
}
DI void attn_phase(const Args& a, const WS& w, unsigned char* lds, int cid) {
    if (gridDim.x == 256) {
        const int xcd = cid & 7, bx = cid >> 3, bl = bx & 3, x = bx >> 2;
        for (int r = 0; r < 4; ++r) { const int qb = (r & 1) ? (31 - 8 * r - (7 - x)) : (31 - 8 * r - x); attn_item(a, w, lds, 2 * xcd + (bl >> 1), bl & 1, qb); }
    } else {
        for (int t = blockIdx.x; t < NB * 2 * 32; t += gridDim.x) attn_item(a, w, lds, (t & 31) >> 1, t & 1, 31 - (t >> 5));
    }
}

DI void convfix_phase(const Args& a, const WS& w) {
    const int nth = gridDim.x * 512;
    for (int task = blockIdx.x * 512 + threadIdx.x; task < (NTOK / 64) * (DFF / 8); task += nth) {
        const int q = task / (DFF / 8), ch = task % (DFF / 8), n0 = ch * 8;
        if ((q & 31) == 0) continue;
        float xa[4][8], xb[4][8];
#pragma unroll
        for (int sl = 0; sl < 4; ++sl) { const u16* hp = w.halo + ((size_t)q * 4 + sl) * NUP + n0; const u32x4 pa = *(const u32x4*)hp, pb = *(const u32x4*)(hp + DFF);
#pragma unroll
            for (int e = 0; e < 4; ++e) { xa[sl][2 * e] = bf_lo(pa[e]); xa[sl][2 * e + 1] = bf_hi(pa[e]); xb[sl][2 * e] = bf_lo(pb[e]); xb[sl][2 * e + 1] = bf_hi(pb[e]); } }
#pragma unroll
        for (int rr = 0; rr < 2; ++rr) {
            float res[8];
#pragma unroll
            for (int e = 0; e < 8; ++e) {
                const float ya = a.conv_b[n0 + e] + a.conv_w[n0 + e] * xa[rr][e] + a.conv_w[NUP + n0 + e] * xa[rr + 1][e] + a.conv_w[2 * NUP + n0 + e] * xa[rr + 2][e];
                const float yb = a.conv_b[DFF + n0 + e] + a.conv_w[DFF + n0 + e] * xb[rr][e] + a.conv_w[NUP + DFF + n0 + e] * xb[rr + 1][e] + a.conv_w[2 * NUP + DFF + n0 + e] * xb[rr + 2][e];
                res[e] = silu_f(ya) * yb;
            }
            u32x4 o; o[0] = pk2(res[0], res[1]); o[1] = pk2(res[2], res[3]); o[2] = pk2(res[4], res[5]); o[3] = pk2(res[6], res[7]);
            *(u32x4*)(w.act + (size_t)(q * 64 + rr) * DFF + n0) = o;
        }
    }
}

__global__ void __launch_bounds__(512, 2) fwd_mega(Args a) {
    extern __shared__ __attribute__((aligned(16))) unsigned char shm[];
    cg::grid_group grid = cg::this_grid();
    const WS w = make_ws(a.ws);
    const int lo = a.ph_lo, hi = a.ph_hi; const bool coop = a.coop != 0;
    volatile XLAS unsigned* xst = (volatile XLAS unsigned*)((XLAS unsigned char*)shm + LDS_BAR_OFF);
    if (threadIdx.x == 0) { xst[0] = 0u; xst[1] = 0u; xst[2] = 0u; xst[3] = 0u; }
    __syncthreads();
    XcdBarrier xb; xb.bar = (unsigned*)(a.ws + WS_BAR); xb.x = 0u; xb.st = xst;
    if (coop) xb = xcd_barrier_post((unsigned*)(a.ws + WS_BAR), xst);
    int cid = (int)blockIdx.x;
    if (coop) {
        if (threadIdx.x == 0) {
            unsigned* bar = (unsigned*)(a.ws + WS_BAR);
            const unsigned G = gridDim.x, x = xb.x;
            const unsigned my = xb_add(&bar[4 * x], 1u);
            unsigned sum = 0u, sp = 0u; bool ok = true;
            for (;;) {
                sum = 0u; ok = ((G & 7u) == 0u);
#pragma unroll
                for (unsigned j = 0; j < 16; ++j) { const unsigned c = xb_ld(&bar[4 * j]); sum += c; if (j < 8 ? (c != G / 8u) : (c != 0u)) ok = false; }
                if (sum == G) break;
                __builtin_amdgcn_s_sleep(1);
                if (++sp > (1u << 20)) { ok = false; break; }
            }
            xst[2] = ok ? (my * 8u + x) : blockIdx.x;
            xst[3] = ok ? 1u : 0u;
        }
        __syncthreads();
        cid = (int)xst[2];
    }
    if (a.pad == 0x5eed) grid.sync();
#ifndef DUP
#define DUP -1
#endif
#ifndef PROBE_PH
#define PROBE_PH -1
#endif
#define REP(n) for (int _r = 0; _r < ((n) == DUP ? 2 : 1); ++_r)
#define PH_BEGIN(n) if (lo <= (n) && (n) < hi) { REP(n) {
#define PH_END(n) } if (coop && (n) + 1 < hi) xcd_barrier(xb); }
    PH_BEGIN(0) phase0(a, w, shm); PH_END(0)
    PH_BEGIN(1) rms_phase<false>(a, w, shm, a.x, a.norm1_g, 0, 2048, w.hbuf, true); PH_END(1)
    PH_BEGIN(2) { const int nrep = (PROBE_PH == 2) ? a.pad : 1;
#pragma unroll 1
    for (int rp = 0; rp < nrep; ++rp) { EpiProj E; E.O = w.proj; run_gemm(shm, w.hbuf, w.wt_in, NTOK, NP, 2048, E, cid); } } convert_wup_tail(a, w, shm, cid); PH_END(2)
    PH_BEGIN(3) REP(30) mixer_a_phase(a, w, shm); REP(31) kv_prep_phase(a, w, shm); REP(32) indexer_phase(a, w, shm); PH_END(3)
    PH_BEGIN(4) attn_phase(a, w, shm, cid); PH_END(4)
    PH_BEGIN(5) { EpiGate E; E.T = w.merged; E.proj = w.proj; E.gcol = C_GA; E.first = 1; run_gemm(shm, w.ya, w.wt_a, NTOK, 2048, 1024, E, cid);
                  EpiGate E2; E2.T = w.merged; E2.proj = w.proj; E2.gcol = C_GB; E2.first = 0; run_gemm(shm, w.yb, w.wt_b, NTOK, 2048, 1024, E2, cid); } PH_END(5)
    PH_BEGIN(6) { EpiResB E; E.O = w.x1b; E.R = a.x; E.mod = w.mod; E.goff = 4096; run_gemm(shm, w.merged, w.wt_out, NTOK, 2048, 2048, E, cid); } PH_END(6)
    PH_BEGIN(7) rms_phase<true>(a, w, shm, w.x1b, a.norm2_g, 6144, 8192, w.hbuf, false); PH_END(7)
    PH_BEGIN(8) { const int nrep = (PROBE_PH == 8) ? a.pad : 1;
#pragma unroll 1
    for (int rp = 0; rp < nrep; ++rp) { EpiConv E; E.act = w.act; E.halo = w.halo; E.cw = a.conv_w; E.cb = a.conv_b; run_gemm(shm, w.hbuf, w.wt_up, NTOK, NUP, 2048, E, cid); } } PH_END(8)
    PH_BEGIN(9) convfix_phase(a, w); PH_END(9)
    PH_BEGIN(10) { const int nrep = (PROBE_PH == 10) ? a.pad : 1;
#pragma unroll 1
    for (int rp = 0; rp < nrep; ++rp) { EpiOut E; E.O = a.out; E.R = w.x1b; E.mod = w.mod; E.goff = 10240; run_gemm(shm, w.act, w.wt_dn, NTOK, 2048, DFF, E, cid); } } PH_END(10)
}

extern "C" void kernel_launch(void* const* d_in, const int* in_sizes, int n_in, void* d_out, int out_size, void* d_ws, size_t ws_size, hipStream_t stream) {
    static int grid = 0;
    if (grid == 0) {
        int dev = 0, cus = 0, per_cu = 0;
        hipGetDevice(&dev); hipDeviceGetAttribute(&cus, hipDeviceAttributeMultiprocessorCount, dev);
        if (hipFuncSetAttribute((const void*)fwd_mega, hipFuncAttributeMaxDynamicSharedMemorySize, LDS_BYTES) != hipSuccess) fprintf(stderr, "kernel_launch: hipFuncSetAttribute failed\n");
        hipOccupancyMaxActiveBlocksPerMultiprocessor(&per_cu, (const void*)fwd_mega, 512, LDS_BYTES);
        (void)hipGetLastError();
        if (per_cu < 1) per_cu = 1;
        grid = cus * 1;
        if (ws_size < WS_END) fprintf(stderr, "kernel_launch: workspace too small: %zu < %zu\n", ws_size, (size_t)WS_END);
        fprintf(stderr, "kernel_launch: cus %d per_cu %d grid %d ws %zu need %zu\n", cus, per_cu, grid, ws_size, (size_t)WS_END);
    }
    Args a{};
    a.x = (const float*)d_in[0]; a.c = (const float*)d_in[1]; a.w_ada = (const float*)d_in[2]; a.b_ada = (const float*)d_in[3]; a.norm1_g = (const float*)d_in[4]; a.w_in = (const float*)d_in[5];
    a.v_norm_g = (const float*)d_in[6]; a.w_spatial = (const float*)d_in[7]; a.b_spatial = (const float*)d_in[8]; a.q_norm_g = (const float*)d_in[9]; a.k_norm_g = (const float*)d_in[10];
    a.w_proj_a = (const float*)d_in[11]; a.w_proj_b = (const float*)d_in[12]; a.w_out = (const float*)d_in[13]; a.norm2_g = (const float*)d_in[14]; a.w_up = (const float*)d_in[15];
    a.conv_w = (const float*)d_in[16]; a.conv_b = (const float*)d_in[17]; a.w_down = (const float*)d_in[18];
    a.out = (float*)d_out; a.ws = (unsigned char*)d_ws;
#if MULTI_LAUNCH
    a.coop = 0;
    for (int ph = 0; ph < NPH; ++ph) { a.ph_lo = ph; a.ph_hi = ph + 1; hipLaunchKernelGGL(fwd_mega, dim3(grid), dim3(512), LDS_BYTES, stream, a); }
#else
    a.coop = 1; a.ph_lo = 0; a.ph_hi = NPH; a.pad = (PROBE_PH >= 0) ? 2 : 0;
    if (hipMemsetAsync((unsigned char*)d_ws + WS_BAR, 0, XCD_BAR_WORDS * 4, stream) != hipSuccess) fprintf(stderr, "kernel_launch: memset of barrier words failed\n");
    void* args[] = {&a};
    hipError_t e = hipLaunchCooperativeKernel((const void*)fwd_mega, dim3(grid), dim3(512), args, LDS_BYTES, stream);
    if (e != hipSuccess) fprintf(stderr, "cooperative launch failed: %s (grid %d)\n", hipGetErrorString(e), grid);
#endif
}
```

```cpp
#include <hip/hip_runtime.h>
#include <hip/hip_cooperative_groups.h>
#include <cstdio>
namespace cg = cooperative_groups;
#define MULTI_LAUNCH 0
namespace pg8 {
#define PG8_LAS __attribute__((address_space(3)))
typedef unsigned short bf16_t;
typedef short bf16x8 __attribute__((ext_vector_type(8)));
typedef float f32x4 __attribute__((ext_vector_type(4)));
typedef unsigned u32x4 __attribute__((ext_vector_type(4)));
constexpr int BM = 256, BK = 64, HALF = 128, HTB = HALF * BK * 2  , STAGE_BYTES = 8 * HTB, NXCD = 8, WGM = 4;

__host__ __device__ __forceinline__ int lds_byte(int r, int c) { const int st = (r >> 4) * 2 + (c >> 5), rr = r & 15, cc = c & 31, ob = rr * 64 + cc * 2; return st * 1024 + (ob ^ (((ob >> 9) & 1) << 5)); }
__host__ __device__ __forceinline__ void stage_rc(int b, int& R, int& C) { const int st = b / 1024, sb = b % 1024, swz = sb ^ (((sb >> 9) & 1) << 5); R = (st >> 1) * 16 + swz / 64; C = (st & 1) * 32 + (swz % 64) / 2; }
__host__ __device__ __forceinline__ int perm32(int rho) { const int n = rho >> 4, i = rho & 15; return 8 * (i >> 2) + 4 * n + (i & 3); }

struct Unit { int pm, pn; };
struct Gemm { const bf16_t* A; const bf16_t* Bt; int M, N, K; };

struct StaticOrder {
    int nM, nN, nwg, G, c;
    __host__ __device__ void init(int M, int N, int G_, int c_) { nM = M / BM; nN = N / BM; nwg = nM * nN; G = G_; c = c_; }
    __host__ __device__ bool next(int i, Unit& u) const {
        const long L = (long)i * G + c; if (L >= nwg) return false;
        int wgid = (int)L; { const int q = nwg / NXCD, r = nwg % NXCD, xcd = wgid % NXCD, off = wgid / NXCD; wgid = (xcd < r ? xcd * (q + 1) : r * (q + 1) + (xcd - r) * q) + off; }
        const int nig = WGM * nN, gid = wgid / nig, fm = gid * WGM, gsz = (nM - fm) < WGM ? (nM - fm) : WGM;
        u.pm = fm + ((wgid % nig) % gsz); u.pn = (wgid % nig) / gsz; return true;
    }
    __device__ __forceinline__ void a_ready(const Unit&) const {}
    __device__ __forceinline__ void done(const Unit&) const {}
};
__device__ __forceinline__ unsigned cvt_pk_bf16(float lo, float hi) { unsigned r; asm volatile("v_cvt_pk_bf16_f32 %0, %1, %2" : "=v"(r) : "v"(lo), "v"(hi)); return r; }

template <class Epi, class Sched, bool STAMP = false>
__device__ __forceinline__ void gemm_phase(PG8_LAS unsigned char* lds, const Gemm g, const Sched& S, const Epi& E, unsigned long long* stamps) {
    const int tid = threadIdx.x, wid = __builtin_amdgcn_readfirstlane(tid >> 6), lane = tid & 63, wr = wid >> 2, wc = wid & 3, fr = lane & 15, fq = lane >> 4;
    const int K = g.K, nt = K / BK;
    int ts_lo = 0, ts_hi = 0, nts = 0; const unsigned long long rt_entry = STAMP ? (unsigned long long)wall_clock64() : 0ull;
#define PG8_STAMP() do { if (STAMP && wid == 0 && nts < 64) { const unsigned long long _c = (unsigned long long)clock64(); \
        ts_lo = (lane == nts) ? (int)(unsigned)_c : ts_lo; ts_hi = (lane == nts) ? (int)(unsigned)(_c >> 32) : ts_hi; ++nts; } } while (0)
    PG8_STAMP();
    unsigned voffA[2], voffB[2];
#pragma unroll
    for (int i = 0; i < 2; ++i) { int R, C; stage_rc(tid * 16 + i * 8192, R, C); const int Rb = Epi::PERM ? ((R & ~31) + perm32(R & 31)) : R;
        voffA[i] = (unsigned)(R * K + C) * 2u; voffB[i] = (unsigned)(Rb * K + C) * 2u; }
    const size_t kstep = (size_t)(BK * 2);
    const size_t hstep = (size_t)HALF * K * 2;
    const size_t tstep = 2 * hstep;
    const unsigned ldsw = (unsigned)wid * 1024u;
    const int aoff = lds_byte(wr * 64 + fr, fq * 8), boff = lds_byte(wc * 32 + fr, fq * 8);
#define PG8_SA(b, h) (((b) * 2 + (h)) * HTB)
#define PG8_SB(b, h) ((4 + (b) * 2 + (h)) * HTB)
#define PG8_STAGE(bufoff, gbase, voff) do { _Pragma("unroll") for (int _i = 0; _i < 2; ++_i) \
        __builtin_amdgcn_global_load_lds((const unsigned*)((const char*)(gbase) + (voff)[_i]), (PG8_LAS unsigned*)(lds + (bufoff) + ldsw + _i * 8192), 16, 0, 0); } while (0)
#define PG8_LDA(dst, b, h) do { _Pragma("unroll") for (int m = 0; m < 4; ++m) _Pragma("unroll") for (int k = 0; k < 2; ++k) dst[m][k] = *(const PG8_LAS bf16x8*)(lds + PG8_SA(b, h) + aoff + m * 2048 + k * 1024); } while (0)
#define PG8_LDB(dst, b, h) do { _Pragma("unroll") for (int n = 0; n < 2; ++n) _Pragma("unroll") for (int k = 0; k < 2; ++k) dst[n][k] = *(const PG8_LAS bf16x8*)(lds + PG8_SB(b, h) + boff + n * 2048 + k * 1024); } while (0)
#define PG8_MMA(ai, bj, At, Bt) do { __builtin_amdgcn_s_setprio(1); _Pragma("unroll") for (int m = 0; m < 4; ++m) _Pragma("unroll") for (int n = 0; n < 2; ++n) _Pragma("unroll") for (int k = 0; k < 2; ++k) \
        acc[ai][bj][m][n] = __builtin_amdgcn_mfma_f32_16x16x32_bf16(Bt[n][k], At[m][k], acc[ai][bj][m][n], 0, 0, 0); __builtin_amdgcn_s_setprio(0); } while (0)
#define PG8_WAIT_V(n) asm volatile("s_waitcnt vmcnt(" #n ")" ::: "memory")
#define PG8_WAIT_L(n) asm volatile("s_waitcnt lgkmcnt(" #n ")" ::: "memory")
#define PG8_BAR __builtin_amdgcn_s_barrier()
#define PG8_SCHED __builtin_amdgcn_sched_barrier(0)
    Unit cur, nxt; int ui = 0;
    if (!S.next(0, cur)) return;
    f32x4 acc[2][2][4][2];
#pragma unroll
    for (int a = 0; a < 2; ++a)
#pragma unroll
        for (int b = 0; b < 2; ++b)
#pragma unroll
            for (int m = 0; m < 4; ++m)
#pragma unroll
                for (int n = 0; n < 2; ++n) acc[a][b][m][n] = (f32x4){0.f, 0.f, 0.f, 0.f};
    bf16x8 At[4][2], B0[2][2], B1[2][2];
    const char* cA = (const char*)g.A + (size_t)cur.pm * tstep; const char* cB = (const char*)g.Bt + (size_t)cur.pn * tstep;
    S.a_ready(cur);
    PG8_STAGE(PG8_SB(0, 0), cB, voffB); PG8_STAGE(PG8_SA(0, 0), cA, voffA); PG8_STAGE(PG8_SB(0, 1), cB + hstep, voffB); PG8_STAGE(PG8_SA(0, 1), cA + hstep, voffA);
    if (wr == 1) PG8_BAR;
    PG8_WAIT_V(4); PG8_BAR;
    PG8_STAGE(PG8_SB(1, 0), cB + kstep, voffB); PG8_STAGE(PG8_SA(1, 0), cA + kstep, voffA); PG8_STAGE(PG8_SB(1, 1), cB + hstep + kstep, voffB);
    PG8_WAIT_V(6); PG8_BAR;
    PG8_STAMP();
    for (;;) {
        const bool has_next = S.next(ui + 1, nxt);
        const char* nA = has_next ? (const char*)g.A + (size_t)nxt.pm * tstep : cA; const char* nB = has_next ? (const char*)g.Bt + (size_t)nxt.pn * tstep : cB;
        for (int t = 0; t < nt; t += 2) {
            const bool last = (t == nt - 2);
            const char* a1 = cA + (size_t)(t + 1) * kstep;
            const char* a2 = last ? nA : cA + (size_t)(t + 2) * kstep; const char* b2 = last ? nB : cB + (size_t)(t + 2) * kstep;
            const char* a3 = a2 + kstep; const char* b3 = b2 + kstep;
            if (last && has_next) S.a_ready(nxt);
            PG8_LDB(B0, 0, 0); PG8_SCHED; PG8_LDA(At, 0, 0); PG8_STAGE(PG8_SA(1, 1), a1 + hstep, voffA);
            PG8_WAIT_L(8); PG8_BAR; PG8_WAIT_L(0); PG8_MMA(0, 0, At, B0); PG8_BAR; PG8_SCHED;
            PG8_LDB(B1, 0, 1); PG8_STAGE(PG8_SB(0, 0), b2, voffB);
            PG8_BAR; PG8_WAIT_L(0); PG8_MMA(0, 1, At, B1); PG8_BAR;
            PG8_LDA(At, 0, 1); PG8_STAGE(PG8_SA(0, 0), a2, voffA);
            PG8_BAR; PG8_WAIT_L(0); PG8_MMA(1, 0, At, B0); PG8_BAR; PG8_SCHED;
            PG8_STAGE(PG8_SB(0, 1), b2 + hstep, voffB);
            PG8_WAIT_V(6); PG8_BAR; PG8_MMA(1, 1, At, B1); PG8_BAR;
            PG8_LDB(B0, 1, 0); PG8_SCHED; PG8_LDA(At, 1, 0); PG8_STAGE(PG8_SA(0, 1), a2 + hstep, voffA);
            PG8_WAIT_L(8); PG8_BAR; PG8_WAIT_L(0); PG8_MMA(0, 0, At, B0); PG8_BAR; PG8_SCHED;
            PG8_LDB(B1, 1, 1); PG8_STAGE(PG8_SB(1, 0), b3, voffB);
            PG8_BAR; PG8_WAIT_L(0); PG8_MMA(0, 1, At, B1); PG8_BAR;
            PG8_LDA(At, 1, 1); PG8_STAGE(PG8_SA(1, 0), a3, voffA);
            PG8_BAR; PG8_WAIT_L(0); PG8_MMA(1, 0, At, B0); PG8_BAR; PG8_SCHED;
            PG8_STAGE(PG8_SB(1, 1), b3 + hstep, voffB);
            PG8_WAIT_V(6); PG8_BAR; PG8_MMA(1, 1, At, B1); PG8_BAR;
        }
        PG8_STAMP();
        if constexpr (!Epi::AFTER_DRAIN) { E(acc, cur, wr, wc, fr, fq); S.done(cur); }
        PG8_STAMP();
        if (!has_next) break;
#pragma unroll
        for (int a = 0; a < 2; ++a)
#pragma unroll
            for (int b = 0; b < 2; ++b)
#pragma unroll
                for (int m = 0; m < 4; ++m)
#pragma unroll
                    for (int n = 0; n < 2; ++n) acc[a][b][m][n] = (f32x4){0.f, 0.f, 0.f, 0.f};
        cur = nxt; cA = nA; cB = nB; ++ui;
    }
    PG8_WAIT_V(0);
    if (wr == 0) PG8_BAR;
    PG8_BAR;
    if constexpr (Epi::AFTER_DRAIN) { E.fused(acc, cur, wr, wc, fr, fq, lds, wid, lane); S.done(cur); }
    PG8_STAMP();
    if (STAMP && wid == 0) { stamps[lane] = lane < nts ? (((unsigned long long)(unsigned)ts_hi << 32) | (unsigned)ts_lo) : 0ull;
        if (lane == 62) stamps[62] = rt_entry; if (lane == 63) stamps[63] = (unsigned long long)wall_clock64(); }
#undef PG8_STAMP
#undef PG8_SA
#undef PG8_SB
#undef PG8_STAGE
#undef PG8_LDA
#undef PG8_LDB
#undef PG8_MMA
#undef PG8_WAIT_V
#undef PG8_WAIT_L
#undef PG8_BAR
#undef PG8_SCHED
}
}
#define XB_TMO      128
#define XB_XCNT(j)  (256  + 64 * (j))
#define XB_XSUB(j)  (1280 + 64 * (j))
#define XB_XGEN(j)  (2304 + 64 * (j))
#define XB_TOP      3328
#define XB_TOPGEN   3392
#define XCD_BAR_WORDS 3456
#define XB_SPIN_CAP (1u << 18)
#define XLAS __attribute__((address_space(3)))

__device__ __forceinline__ unsigned xb_ld(unsigned* p)              { return __hip_atomic_load(p, __ATOMIC_RELAXED, __HIP_MEMORY_SCOPE_AGENT); }
__device__ __forceinline__ unsigned xb_add(unsigned* p, unsigned v) { return __hip_atomic_fetch_add(p, v, __ATOMIC_RELAXED, __HIP_MEMORY_SCOPE_AGENT); }
__device__ __forceinline__ unsigned xb_xcc_id() { return (unsigned)__builtin_amdgcn_s_getreg((3 << 11) | 20) & 0xFu; }
#define XB_SPIN(cond, bar) do { unsigned _sp = 0; while (cond) { __builtin_amdgcn_s_sleep(1); \
    if ((++_sp & 255u) == 0u) { if (xb_ld(&(bar)[XB_TMO])) break; if (_sp > XB_SPIN_CAP) { atomicAdd(&(bar)[XB_TMO], 1u); break; } } } } while (0)

struct XcdBarrier {
    unsigned* bar; unsigned x;
    volatile XLAS unsigned* st;
};

__device__ __forceinline__ XcdBarrier xcd_barrier_post(unsigned* bar, volatile XLAS unsigned* st) {
    XcdBarrier b; b.bar = bar; b.x = xb_xcc_id(); b.st = st;
    if (threadIdx.x == 0) (void)xb_add(&bar[XB_XCNT(b.x)], 1u);
    return b;
}
__device__ __forceinline__ void xcd_barrier_complete(unsigned* bar, unsigned x, unsigned& nloc, unsigned& nx) {
    const unsigned G = gridDim.x * gridDim.y * gridDim.z;
    unsigned sum, cnt, mine, sp = 0u;
    for (;;) {
        sum = 0u; cnt = 0u; mine = 0u;
#pragma unroll
        for (unsigned j = 0; j < 16; ++j) { const unsigned c = xb_ld(&bar[XB_XCNT(j)]); sum += c; cnt += (c > 0u) ? 1u : 0u; mine = (j == x) ? c : mine; }
        if (sum == G) break;
        __builtin_amdgcn_s_sleep(1);
        if ((++sp & 255u) == 0u) { if (xb_ld(&bar[XB_TMO])) break; if (sp > XB_SPIN_CAP) { atomicAdd(&bar[XB_TMO], 1u); break; } }
    }
    nloc = mine > 0u ? mine : 1u; nx = cnt > 0u ? cnt : 1u;
}

__device__ __forceinline__ void xcd_barrier(const XcdBarrier& b) {
    asm volatile("s_waitcnt vmcnt(0)" ::: "memory");
    __syncthreads();
    if (threadIdx.x == 0) {
        unsigned* bar = b.bar;
        __builtin_amdgcn_s_waitcnt(0);
        unsigned nloc = b.st[0], nx = b.st[1];
        if (nloc == 0u) { xcd_barrier_complete(bar, b.x, nloc, nx); b.st[0] = nloc; b.st[1] = nx; }
        const unsigned old = xb_add(&bar[XB_XSUB(b.x)], 1u);
        const unsigned gen = old / nloc;
        if (old + 1u == (gen + 1u) * nloc) {
            __builtin_amdgcn_fence(__ATOMIC_RELEASE, "agent");
            asm volatile("s_waitcnt vmcnt(0)" ::: "memory");
            const unsigned og = xb_add(&bar[XB_TOP], 1u);
            const unsigned tg = og / nx;
            if (og + 1u == (tg + 1u) * nx) xb_add(&bar[XB_TOPGEN], 1u);
            else XB_SPIN(xb_ld(&bar[XB_TOPGEN]) == tg, bar);
            __builtin_amdgcn_fence(__ATOMIC_ACQUIRE, "agent");
            xb_add(&bar[XB_XGEN(b.x)], 1u);
            asm volatile("s_waitcnt vmcnt(0)" ::: "memory");
        } else {
            XB_SPIN(xb_ld(&bar[XB_XGEN(b.x)]) == gen, bar);
            __builtin_amdgcn_fence(__ATOMIC_ACQUIRE, "agent");
            asm volatile("s_waitcnt vmcnt(0)" ::: "memory");
        }
    }
    __syncthreads();
}
typedef unsigned short u16; typedef unsigned int u32;
typedef u32 u32x2 __attribute__((ext_vector_type(2)));
typedef u32 u32x4 __attribute__((ext_vector_type(4)));
typedef float f32x16 __attribute__((ext_vector_type(16)));
typedef __bf16 bf16v2 __attribute__((ext_vector_type(2)));
using pg8::bf16x8; using pg8::f32x4;
#define DI __device__ __forceinline__
DI u32 pk2(float a, float b) { bf16v2 v = {(__bf16)a, (__bf16)b}; return __builtin_bit_cast(u32, v); }
DI float bf_lo(u32 w) { return __uint_as_float(w << 16); }
DI float bf_hi(u32 w) { return __uint_as_float(w & 0xffff0000u); }
DI float bf2f(u16 h) { return __uint_as_float((u32)h << 16); }
DI float fast_sigmoid(float x) { return __builtin_amdgcn_rcpf(1.0f + __builtin_amdgcn_exp2f(-1.44269504089f * x)); }
DI float gelu_tanh(float x) { const float z = 0.7978845608f * (x + 0.044715f * x * x * x); return x * fast_sigmoid(2.0f * z); }
DI float silu_f(float x) { return x * fast_sigmoid(x); }

constexpr int NB = 16, SEQ = 2048, DM = 2048, NTOK = NB * SEQ;
constexpr int NP = 8960;
constexpr int C_U = 0, C_VA = 1024, C_Q = 2048, C_QI = 3072, C_GA = 4096, C_GB = 6144, C_K = 8192, C_VB = 8448, C_KI = 8704, C_WI = 8768;
constexpr int DFF = 5632, NUP = 11264, NMOD = 12288, KSPL = 32;
constexpr int HALF_TOK = NTOK / 2;
constexpr float EPSN = 1e-6f;
constexpr int LDS_BAR_OFF = 131072 + 3 * 8192, LDS_BYTES = LDS_BAR_OFF + 16;
constexpr int NPH = 11;

constexpr size_t WS_WT_IN = 0;
constexpr size_t WS_WT_A = WS_WT_IN + (size_t)NP * 2048 * 2;
constexpr size_t WS_WT_B = WS_WT_A + (size_t)2048 * 1024 * 2;
constexpr size_t WS_WT_OUT = WS_WT_B + (size_t)2048 * 1024 * 2;
constexpr size_t WS_WT_UP = WS_WT_OUT + (size_t)2048 * 2048 * 2;
constexpr size_t WS_WT_DN = WS_WT_UP + (size_t)NUP * 2048 * 2;
constexpr size_t WS_MODP = WS_WT_DN + (size_t)2048 * DFF * 2;
constexpr size_t WS_MOD = WS_MODP + (size_t)KSPL * NB * NMOD * 4;
constexpr size_t WS_MASK = WS_MOD + (size_t)NB * NMOD * 4;
constexpr size_t WS_KN = WS_MASK + (size_t)NTOK * 64 * 4;
constexpr size_t WS_VT = WS_KN + (size_t)NTOK * 256 * 2;
constexpr size_t WS_HBUF = WS_VT + (size_t)NTOK * 256 * 2;
constexpr size_t WS_MERGED = WS_HBUF + (size_t)NTOK * 2048 * 2;
constexpr size_t WS_PROJ = WS_MERGED + (size_t)NTOK * 2048 * 2;
constexpr size_t WS_ACT = WS_PROJ;
constexpr size_t WS_HALO = WS_ACT + (size_t)NTOK * DFF * 2;
constexpr size_t WS_BAR = WS_PROJ + (size_t)NTOK * NP * 2;
constexpr size_t WS_END = WS_BAR + 16384;
constexpr size_t WS_X1B = WS_HALO + (size_t)513 * 4 * NUP * 2;
static_assert(WS_X1B + (size_t)NTOK * 2048 * 2 <= WS_PROJ + (size_t)NTOK * NP * 2, "ws alias");

struct Args {
    const float *x, *c, *w_ada, *b_ada, *norm1_g, *w_in, *v_norm_g, *w_spatial, *b_spatial, *q_norm_g, *k_norm_g, *w_proj_a, *w_proj_b, *w_out, *norm2_g, *w_up, *conv_w, *conv_b, *w_down;
    float* out; unsigned char* ws; int ph_lo, ph_hi, coop, pad;
};
struct WS {
    u16 *wt_in, *wt_a, *wt_b, *wt_out, *wt_up, *wt_dn; float *modp, *mod; u32* mask; u16 *kn, *vt, *hbuf, *ya, *yb, *merged, *proj, *halo, *act, *x1b;
};
DI WS make_ws(unsigned char* p) {
    WS w; w.wt_in = (u16*)(p + WS_WT_IN); w.wt_a = (u16*)(p + WS_WT_A); w.wt_b = (u16*)(p + WS_WT_B); w.wt_out = (u16*)(p + WS_WT_OUT); w.wt_up = (u16*)(p + WS_WT_UP); w.wt_dn = (u16*)(p + WS_WT_DN);
    w.modp = (float*)(p + WS_MODP); w.mod = (float*)(p + WS_MOD); w.mask = (u32*)(p + WS_MASK); w.kn = (u16*)(p + WS_KN); w.vt = (u16*)(p + WS_VT); w.hbuf = (u16*)(p + WS_HBUF);
    w.ya = w.hbuf; w.yb = w.hbuf + (size_t)NTOK * 1024; w.merged = (u16*)(p + WS_MERGED); w.proj = (u16*)(p + WS_PROJ); w.halo = (u16*)(p + WS_HALO); w.act = (u16*)(p + WS_ACT); w.x1b = (u16*)(p + WS_X1B);
    return w;
}

DI int map_in(int n) {
    if (n < 3072) return n;
    if (n < 3328) return n - 3072 + C_K;
    if (n < 3584) return n - 3328 + C_VB;
    if (n < 4608) return n - 3584 + C_QI;
    if (n < 4672) return n - 4608 + C_KI;
    if (n < 4688) return n - 4672 + C_WI;
    if (n < 6736) return n - 4688 + C_GA;
    return n - 6736 + C_GB;
}
DI int conv_dst_row(int mode, int n2) {
    return (mode == 1) ? map_in(n2) : (mode == 2) ? ((n2 < DFF) ? ((n2 >> 7) * 256 + (n2 & 127)) : (((n2 - DFF) >> 7) * 256 + 128 + ((n2 - DFF) & 127))) : n2;
}
DI void conv_tiles4(const float* __restrict__ src, u16* __restrict__ dst, int K, int N, int nkt, int t0, int tstep, int cnt, int mode, float* tile) {
    const int tid = threadIdx.x, tx = tid & 63, ty = tid >> 6;
    float v[4][8];
#pragma unroll
    for (int q = 0; q < 4; ++q) {
        const int t = t0 + q * tstep;
        if (t < cnt) { const int kt = t % nkt, nt = t / nkt, n = nt * 64 + tx;
#pragma unroll
            for (int i = 0; i < 8; ++i) v[q][i] = (n < N) ? __builtin_nontemporal_load(src + (size_t)(kt * 64 + ty * 8 + i) * N + n) : 0.f; }
    }
#pragma unroll
    for (int q = 0; q < 4; ++q) {
        if (t0 + q * tstep < cnt) {
#pragma unroll
            for (int i = 0; i < 8; ++i) tile[q * 4160 + (ty * 8 + i) * 65 + tx] = v[q][i]; }
    }
    __syncthreads();
    const int nl = tid >> 3, kc = tid & 7;
#pragma unroll
    for (int q = 0; q < 4; ++q) {
        const int t = t0 + q * tstep;
        if (t < cnt) { const int kt = t % nkt, nt = t / nkt, n2 = nt * 64 + nl;
            if (n2 < N) {
                const int dn = conv_dst_row(mode, n2);
                u32x4 o;
#pragma unroll
                for (int e = 0; e < 4; ++e) o[e] = pk2(tile[q * 4160 + (kc * 8 + 2 * e) * 65 + nl], tile[q * 4160 + (kc * 8 + 2 * e + 1) * 65 + nl]);
                *(u32x4*)(dst + (size_t)dn * K + kt * 64 + kc * 8) = o;
            } }
    }
    __syncthreads();
}
DI void convert_wup_tail(const Args& a, const WS& w, unsigned char* lds, int cid) {
    if (gridDim.x != 256 || cid < 128) return;
    float* tile = (float*)lds;
    const int nkt = 2048 / 64, cnt = nkt * (NUP / 64);
    for (int t = cid - 128; t < cnt; t += 4 * 128) conv_tiles4(a.w_up, w.wt_up, 2048, NUP, nkt, t, 128, cnt, 2, tile);
}
DI void phase0(const Args& a, const WS& w, unsigned char* lds) {
    float* tile = (float*)lds;
    const float* srcs[6] = {a.w_in, a.w_proj_a, a.w_proj_b, a.w_out, a.w_up, a.w_down};
    u16* dsts[6] = {w.wt_in, w.wt_a, w.wt_b, w.wt_out, w.wt_up, w.wt_dn};
    const int Ks[6] = {2048, 1024, 1024, 2048, 2048, DFF}, Ns[6] = {8784, 2048, 2048, 2048, NUP, 2048};
    int base = 0;
    const bool defer_up = (gridDim.x == 256);
#pragma unroll
    for (int i = 0; i < 6; ++i) {
        if (i == 4 && defer_up) continue;
        const int nkt = Ks[i] / 64, nnt = (Ns[i] + 63) / 64, cnt = nkt * nnt;
        int first = (int)blockIdx.x - (base % (int)gridDim.x); if (first < 0) first += gridDim.x;
        for (int t = first; t < cnt; t += 4 * gridDim.x) conv_tiles4(srcs[i], dsts[i], Ks[i], Ns[i], nkt, t, (int)gridDim.x, cnt, (i == 0) ? 1 : ((i == 4) ? 2 : 0), tile);
        base += cnt;
    }
    { u32x4 z = {0u, 0u, 0u, 0u}; u32x4* p = (u32x4*)(w.wt_in + (size_t)8784 * 2048); const int n16 = (NP - 8784) * 2048 / 8;
      for (int i = blockIdx.x * 512 + threadIdx.x; i < n16; i += gridDim.x * 512) p[i] = z; }
    float* sl = (float*)lds;
    for (int item = blockIdx.x; item < KSPL * 24; item += gridDim.x) {
        const int ks = item / 24, nc = item % 24;
        __syncthreads();
        for (int e = threadIdx.x; e < 1024; e += 512) { const int k = e >> 4, b = e & 15; const float cv = a.c[b * 2048 + ks * 64 + k]; sl[e] = silu_f(cv); }
        __syncthreads();
        const int n = nc * 512 + threadIdx.x;
        float acc[16];
#pragma unroll
        for (int b = 0; b < 16; ++b) acc[b] = 0.f;
        const float* wp = a.w_ada + (size_t)(ks * 64) * NMOD + n;
#pragma unroll 1
        for (int kb = 0; kb < 64; kb += 32) {
            float wv[32];
#pragma unroll
            for (int k = 0; k < 32; ++k) wv[k] = __builtin_nontemporal_load(wp + (size_t)(kb + k) * NMOD);
#pragma unroll
            for (int k = 0; k < 32; ++k) {
                const f32x4* s4 = (const f32x4*)(sl + (kb + k) * 16);
#pragma unroll
                for (int q = 0; q < 4; ++q) { const f32x4 s = s4[q]; acc[4 * q] += s[0] * wv[k]; acc[4 * q + 1] += s[1] * wv[k]; acc[4 * q + 2] += s[2] * wv[k]; acc[4 * q + 3] += s[3] * wv[k]; }
            }
        }
#pragma unroll
        for (int b = 0; b < 16; ++b) w.modp[((size_t)ks * 16 + b) * NMOD + n] = acc[b];
    }
    __syncthreads();
}

template <bool INBF> DI void rms_phase(const Args& a, const WS& w, unsigned char* lds, const void* __restrict__ xin_v, const float* __restrict__ g, int sh_off, int sc_off, u16* __restrict__ hout, bool finalize) {
    const float* xin = (const float*)xin_v; const u16* xinb = (const u16*)xin_v;
    float* gs = (float*)lds; float* shs = gs + 2048;
    const int lane = threadIdx.x & 63, wave = __builtin_amdgcn_readfirstlane(threadIdx.x >> 6);
    if (finalize) {
        for (int e = blockIdx.x * 512 + threadIdx.x; e < NB * NMOD; e += gridDim.x * 512) {
            const int b = e / NMOD, n = e % NMOD; float s = a.b_ada[n];
            float pv[KSPL];
#pragma unroll
            for (int ks = 0; ks < KSPL; ++ks) pv[ks] = w.modp[((size_t)ks * 16 + b) * NMOD + n];
#pragma unroll
            for (int ks = 0; ks < KSPL; ++ks) s += pv[ks];
            w.mod[e] = s;
        }
    }
    for (int rb = blockIdx.x; rb < NTOK / 128; rb += gridDim.x) {
        const int b = rb / 16;
        __syncthreads();
        for (int c = threadIdx.x; c < 2048; c += 512) {
            float sc = a.b_ada[sc_off + c], sh = a.b_ada[sh_off + c];
            if (finalize) {
                float p0[KSPL], p1[KSPL];
#pragma unroll
                for (int ks = 0; ks < KSPL; ++ks) { const float* mp = w.modp + ((size_t)ks * 16 + b) * NMOD; p0[ks] = mp[sc_off + c]; p1[ks] = mp[sh_off + c]; }
#pragma unroll
                for (int ks = 0; ks < KSPL; ++ks) { sc += p0[ks]; sh += p1[ks]; }
            } else { sc = w.mod[(size_t)b * NMOD + sc_off + c]; sh = w.mod[(size_t)b * NMOD + sh_off + c]; }
            gs[c] = g[c] * (1.0f + sc); shs[c] = sh;
        }
        __syncthreads();
        f32x4 nx[8];
        if (!INBF) { const f32x4* xp = (const f32x4*)(xin + ((size_t)rb * 128 + wave * 16) * 2048);
#pragma unroll
          for (int i = 0; i < 8; ++i) nx[i] = __builtin_nontemporal_load(xp + i * 64 + lane); }
        u32x4 nb[4];
        if (INBF) { const u32x4* xp = (const u32x4*)(xinb + ((size_t)rb * 128 + wave * 16) * 2048);
#pragma unroll
          for (int i = 0; i < 4; ++i) nb[i] = xp[i * 64 + lane]; }
#pragma unroll 1
        for (int r = 0; r < 16; ++r) {
            const size_t row = (size_t)rb * 128 + wave * 16 + r;
            f32x4 v[8]; float ss = 0.f;
            if (!INBF) {
#pragma unroll
                for (int i = 0; i < 8; ++i) v[i] = nx[i];
                if (r + 1 < 16) { const f32x4* xp = (const f32x4*)(xin + (row + 1) * 2048);
#pragma unroll
                    for (int i = 0; i < 8; ++i) nx[i] = __builtin_nontemporal_load(xp + i * 64 + lane); }
            } else {
#pragma unroll
                for (int i = 0; i < 4; ++i) { v[2 * i] = (f32x4){bf_lo(nb[i][0]), bf_hi(nb[i][0]), bf_lo(nb[i][1]), bf_hi(nb[i][1])}; v[2 * i + 1] = (f32x4){bf_lo(nb[i][2]), bf_hi(nb[i][2]), bf_lo(nb[i][3]), bf_hi(nb[i][3])}; }
                if (r + 1 < 16) { const u32x4* xp = (const u32x4*)(xinb + (row + 1) * 2048);
#pragma unroll
                    for (int i = 0; i < 4; ++i) nb[i] = xp[i * 64 + lane]; }
            }
#pragma unroll
            for (int i = 0; i < 8; ++i) ss += v[i][0] * v[i][0] + v[i][1] * v[i][1] + v[i][2] * v[i][2] + v[i][3] * v[i][3];
#pragma unroll
            for (int o = 32; o >= 1; o >>= 1) ss += __shfl_xor(ss, o);
            const float rstd = rsqrtf(ss * (1.0f / 2048.0f) + EPSN);
#pragma unroll
            for (int i = 0; i < 8; ++i) {
                const int col = INBF ? (((i >> 1) * 64 + lane) * 8 + (i & 1) * 4) : ((i * 64 + lane) * 4); const f32x4 gg = *(const f32x4*)(gs + col), hh = *(const f32x4*)(shs + col);
                u32x2 o; o[0] = pk2(v[i][0] * rstd * gg[0] + hh[0], v[i][1] * rstd * gg[1] + hh[1]); o[1] = pk2(v[i][2] * rstd * gg[2] + hh[2], v[i][3] * rstd * gg[3] + hh[3]);
                *(u32x2*)(hout + row * 2048 + col) = o;
            }
        }
    }
    __syncthreads();
}
using pg8::Unit; using pg8::BM; using pg8::HALF;
struct EpiProj {
    static constexpr bool PERM = true, AFTER_DRAIN = false;
    u16* O;
    __device__ __forceinline__ void operator()(const f32x4 (&acc)[2][2][4][2], const Unit& u, int wr, int wc, int fr, int fq) const {
        const int row0 = u.pm * BM + wr * 64 + fr, col0 = u.pn * BM + wc * 32 + 8 * fq;
        const int mode = (u.pn < 8) ? 1 : ((u.pn >= 16 && u.pn < 32) ? 2 : 0);
#pragma unroll
        for (int ai = 0; ai < 2; ++ai)
#pragma unroll
            for (int m = 0; m < 4; ++m) { u16* rowp = O + (size_t)(row0 + ai * HALF + m * 16) * NP + col0;
#pragma unroll
                for (int bj = 0; bj < 2; ++bj) { float v[8];
#pragma unroll
                    for (int e = 0; e < 4; ++e) { v[e] = acc[ai][bj][m][0][e]; v[4 + e] = acc[ai][bj][m][1][e]; }
                    if (mode == 1) {
#pragma unroll
                        for (int e = 0; e < 8; ++e) v[e] = gelu_tanh(v[e]);
                    } else if (mode == 2) {
#pragma unroll
                        for (int e = 0; e < 8; ++e) v[e] = fast_sigmoid(v[e]);
                    }
                    u32x4 o; o[0] = pk2(v[0], v[1]); o[1] = pk2(v[2], v[3]); o[2] = pk2(v[4], v[5]); o[3] = pk2(v[6], v[7]);
                    *(u32x4*)(rowp + bj * HALF) = o; } }
    }
};
struct EpiGate {
    static constexpr bool PERM = true, AFTER_DRAIN = false;
    u16* T; const u16* proj; int gcol; int first;
    __device__ __forceinline__ void operator()(const f32x4 (&acc)[2][2][4][2], const Unit& u, int wr, int wc, int fr, int fq) const {
        const int row0 = u.pm * BM + wr * 64 + fr, col0 = u.pn * BM + wc * 32 + 8 * fq;
#pragma unroll
        for (int ai = 0; ai < 2; ++ai)
#pragma unroll
            for (int m = 0; m < 4; ++m) { const size_t row = (size_t)(row0 + ai * HALF + m * 16);
#pragma unroll
                for (int bj = 0; bj < 2; ++bj) { const int col = col0 + bj * HALF;
                    const u32x4 gw = *(const u32x4*)(proj + row * NP + gcol + col);
                    float v[8];
#pragma unroll
                    for (int e = 0; e < 4; ++e) { v[e] = acc[ai][bj][m][0][e]; v[4 + e] = acc[ai][bj][m][1][e]; }
#pragma unroll
                    for (int e = 0; e < 4; ++e) { v[2 * e] *= bf_lo(gw[e]); v[2 * e + 1] *= bf_hi(gw[e]); }
                    u16* tp = T + row * 2048 + col;
                    if (!first) { const u32x4 tw = *(const u32x4*)tp;
#pragma unroll
                        for (int e = 0; e < 4; ++e) { v[2 * e] += bf_lo(tw[e]); v[2 * e + 1] += bf_hi(tw[e]); } }
                    u32x4 o; o[0] = pk2(v[0], v[1]); o[1] = pk2(v[2], v[3]); o[2] = pk2(v[4], v[5]); o[3] = pk2(v[6], v[7]);
                    *(u32x4*)tp = o; } }
    }
};
struct EpiRes {
    static constexpr bool PERM = false, AFTER_DRAIN = false;
    float* O; const float* R; const float* mod; int goff; int row_off;
    __device__ __forceinline__ void operator()(const f32x4 (&acc)[2][2][4][2], const Unit& u, int wr, int wc, int fr, int fq) const {
        const int row0 = row_off + u.pm * BM + wr * 64 + fr, col0 = u.pn * BM + wc * 32 + 4 * fq;
        const int b = (row_off + u.pm * BM) / SEQ;
        f32x4 gv[2][2];
#pragma unroll
        for (int bj = 0; bj < 2; ++bj)
#pragma unroll
            for (int n = 0; n < 2; ++n) gv[bj][n] = *(const f32x4*)(mod + (size_t)b * NMOD + goff + col0 + bj * HALF + n * 16);
#pragma unroll
        for (int ai = 0; ai < 2; ++ai)
#pragma unroll
            for (int m = 0; m < 4; ++m) { const size_t ro = (size_t)(row0 + ai * HALF + m * 16) * 2048 + col0;
#pragma unroll
                for (int bj = 0; bj < 2; ++bj)
#pragma unroll
                    for (int n = 0; n < 2; ++n) { const f32x4 r = *(const f32x4*)(R + ro + bj * HALF + n * 16);
                        *(f32x4*)(O + ro + bj * HALF + n * 16) = r + gv[bj][n] * acc[ai][bj][m][n]; } }
    }
};
struct EpiResB {
    static constexpr bool PERM = true, AFTER_DRAIN = false;
    u16* O; const float* R; const float* mod; int goff;
    __device__ __forceinline__ void operator()(const f32x4 (&acc)[2][2][4][2], const Unit& u, int wr, int wc, int fr, int fq) const {
        const int row0 = u.pm * BM + wr * 64 + fr, col0 = u.pn * BM + wc * 32 + 8 * fq;
        const int b = (u.pm * BM) / SEQ;
        f32x4 gv[2][2];
#pragma unroll
        for (int bj = 0; bj < 2; ++bj)
#pragma unroll
            for (int n = 0; n < 2; ++n) gv[bj][n] = *(const f32x4*)(mod + (size_t)b * NMOD + goff + col0 + bj * HALF + n * 4);
#pragma unroll
        for (int ai = 0; ai < 2; ++ai)
#pragma unroll
            for (int m = 0; m < 4; ++m) { const size_t ro = (size_t)(row0 + ai * HALF + m * 16) * 2048 + col0;
#pragma unroll
                for (int bj = 0; bj < 2; ++bj) {
                    const f32x4 r0 = __builtin_nontemporal_load((const f32x4*)(R + ro + bj * HALF)), r1 = __builtin_nontemporal_load((const f32x4*)(R + ro + bj * HALF + 4));
                    const f32x4 v0 = r0 + gv[bj][0] * acc[ai][bj][m][0], v1 = r1 + gv[bj][1] * acc[ai][bj][m][1];
                    u32x4 o; o[0] = pk2(v0[0], v0[1]); o[1] = pk2(v0[2], v0[3]); o[2] = pk2(v1[0], v1[1]); o[3] = pk2(v1[2], v1[3]);
                    *(u32x4*)(O + ro + bj * HALF) = o; } }
    }
};
struct EpiOut {
    static constexpr bool PERM = true, AFTER_DRAIN = false;
    float* O; const u16* R; const float* mod; int goff;
    __device__ __forceinline__ void operator()(const f32x4 (&acc)[2][2][4][2], const Unit& u, int wr, int wc, int fr, int fq) const {
        const int row0 = u.pm * BM + wr * 64 + fr, col0 = u.pn * BM + wc * 32 + 8 * fq;
        const int b = (u.pm * BM) / SEQ;
        f32x4 gv[2][2];
#pragma unroll
        for (int bj = 0; bj < 2; ++bj)
#pragma unroll
            for (int n = 0; n < 2; ++n) gv[bj][n] = *(const f32x4*)(mod + (size_t)b * NMOD + goff + col0 + bj * HALF + n * 4);
#pragma unroll
        for (int ai = 0; ai < 2; ++ai)
#pragma unroll
            for (int m = 0; m < 4; ++m) { const size_t ro = (size_t)(row0 + ai * HALF + m * 16) * 2048 + col0;
#pragma unroll
                for (int bj = 0; bj < 2; ++bj) {
                    const u32x4 rw = *(const u32x4*)(R + ro + bj * HALF);
                    const f32x4 r0 = (f32x4){bf_lo(rw[0]), bf_hi(rw[0]), bf_lo(rw[1]), bf_hi(rw[1])}, r1 = (f32x4){bf_lo(rw[2]), bf_hi(rw[2]), bf_lo(rw[3]), bf_hi(rw[3])};
                    *(f32x4*)(O + ro + bj * HALF) = r0 + gv[bj][0] * acc[ai][bj][m][0];
                    *(f32x4*)(O + ro + bj * HALF + 4) = r1 + gv[bj][1] * acc[ai][bj][m][1]; } }
    }
};
struct EpiRaw {
    static constexpr bool PERM = true, AFTER_DRAIN = false;
    u16* O; int ldc;
    __device__ __forceinline__ void operator()(const f32x4 (&acc)[2][2][4][2], const Unit& u, int wr, int wc, int fr, int fq) const {
        const int row0 = u.pm * BM + wr * 64 + fr, col0 = u.pn * BM + wc * 32 + 8 * fq;
#pragma unroll
        for (int ai = 0; ai < 2; ++ai)
#pragma unroll
            for (int m = 0; m < 4; ++m) { u16* rowp = O + (size_t)(row0 + ai * HALF + m * 16) * ldc + col0;
#pragma unroll
                for (int bj = 0; bj < 2; ++bj) { const f32x4 v0 = acc[ai][bj][m][0], v1 = acc[ai][bj][m][1];
                    u32x4 o; o[0] = pk2(v0[0], v0[1]); o[1] = pk2(v0[2], v0[3]); o[2] = pk2(v1[0], v1[1]); o[3] = pk2(v1[2], v1[3]);
                    *(u32x4*)(rowp + bj * HALF) = o; } }
    }
};
DI float dpp_ror1(float v) { return __int_as_float(__builtin_amdgcn_mov_dpp(__float_as_int(v), 0x121, 0xF, 0xF, true)); }
DI float dpp_ror2(float v) { return __int_as_float(__builtin_amdgcn_mov_dpp(__float_as_int(v), 0x122, 0xF, 0xF, true)); }
struct EpiConv {
    static constexpr bool PERM = true, AFTER_DRAIN = false;
    u16* act; u16* halo; const float* cw; const float* cb;
    __device__ __forceinline__ void operator()(const f32x4 (&acc)[2][2][4][2], const Unit& u, int wr, int wc, int fr, int fq) const {
        const int col0 = u.pn * 128 + wc * 32 + 8 * fq;
#pragma unroll
        for (int n = 0; n < 2; ++n) {
            const int cbase = col0 + 4 * n;
            const f32x4 wa0 = *(const f32x4*)(cw + cbase), wa1 = *(const f32x4*)(cw + NUP + cbase), wa2 = *(const f32x4*)(cw + 2 * NUP + cbase), ba = *(const f32x4*)(cb + cbase);
            const f32x4 wb0 = *(const f32x4*)(cw + DFF + cbase), wb1 = *(const f32x4*)(cw + NUP + DFF + cbase), wb2 = *(const f32x4*)(cw + 2 * NUP + DFF + cbase), bb = *(const f32x4*)(cb + DFF + cbase);
#pragma unroll
            for (int ai = 0; ai < 2; ++ai) {
                const int rowb = u.pm * BM + ai * HALF + wr * 64;
                const int q = rowb >> 6;
                f32x4 pa1 = (f32x4){0.f, 0.f, 0.f, 0.f}, pa2 = pa1, pb1 = pa1, pb2 = pa1;
#pragma unroll
                for (int m = 0; m < 4; ++m) {
                    const f32x4 xa = acc[ai][0][m][n], xb = acc[ai][1][m][n];
                    f32x4 ca1, ca2, cb1, cb2, res;
#pragma unroll
                    for (int e = 0; e < 4; ++e) { ca1[e] = dpp_ror1(xa[e]); ca2[e] = dpp_ror2(xa[e]); cb1[e] = dpp_ror1(xb[e]); cb2[e] = dpp_ror2(xb[e]); }
#pragma unroll
                    for (int e = 0; e < 4; ++e) {
                        const float a1 = (fr == 0) ? pa1[e] : ca1[e], a2 = (fr < 2) ? pa2[e] : ca2[e];
                        const float b1 = (fr == 0) ? pb1[e] : cb1[e], b2 = (fr < 2) ? pb2[e] : cb2[e];
                        const float ya = ba[e] + wa0[e] * a2 + wa1[e] * a1 + wa2[e] * xa[e];
                        const float yb = bb[e] + wb0[e] * b2 + wb1[e] * b1 + wb2[e] * xb[e];
                        res[e] = silu_f(ya) * yb;
                    }
                    u32x2 o; o[0] = pk2(res[0], res[1]); o[1] = pk2(res[2], res[3]);
                    *(u32x2*)(act + (size_t)(rowb + m * 16 + fr) * DFF + cbase) = o;
                    if (m == 0 && fr < 2) {
                        u16* hp = halo + ((size_t)q * 4 + 2 + fr) * NUP + cbase;
                        u32x2 ha, hb2; ha[0] = pk2(xa[0], xa[1]); ha[1] = pk2(xa[2], xa[3]); hb2[0] = pk2(xb[0], xb[1]); hb2[1] = pk2(xb[2], xb[3]);
                        *(u32x2*)hp = ha; *(u32x2*)(hp + DFF) = hb2;
                    }
                    if (m == 3 && fr >= 14) {
                        u16* hp = halo + ((size_t)(q + 1) * 4 + (fr - 14)) * NUP + cbase;
                        u32x2 ha, hb2; ha[0] = pk2(xa[0], xa[1]); ha[1] = pk2(xa[2], xa[3]); hb2[0] = pk2(xb[0], xb[1]); hb2[1] = pk2(xb[2], xb[3]);
                        *(u32x2*)hp = ha; *(u32x2*)(hp + DFF) = hb2;
                    }
                    pa1 = ca1; pa2 = ca2; pb1 = cb1; pb2 = cb2;
                }
            }
        }
    }
};
template <class Epi> DI void run_gemm(unsigned char* lds, const u16* A, const u16* Bt, int M, int N, int K, const Epi& E, int cid) {
    pg8::Gemm g; g.A = A; g.Bt = Bt; g.M = M; g.N = N; g.K = K;
    pg8::StaticOrder S; S.init(M, N, (int)gridDim.x, cid);
    pg8::gemm_phase<Epi, pg8::StaticOrder, false>((PG8_LAS unsigned char*)lds, g, S, E, nullptr);
    __syncthreads();
}

DI void mixer_a_phase(const Args& a, const WS& w, unsigned char* lds) {
    const int lane = threadIdx.x & 63, wave = __builtin_amdgcn_readfirstlane(threadIdx.x >> 6), fr = lane & 15, fq = lane >> 4;
    float* rstd_s = (float*)lds;
    u16* VT = (u16*)(lds + 1024) + wave * (32 * 136);
    for (int item = blockIdx.x; item < 256; item += gridDim.x) {
        const int t0 = item * 128;
        __syncthreads();
#pragma unroll 1
        for (int rb = 0; rb < 2; ++rb) {
            u32x4 x0[8], x1[8];
#pragma unroll
            for (int r = 0; r < 8; ++r) { const u16* rp = w.proj + (size_t)(t0 + wave * 16 + rb * 8 + r) * NP + C_VA;
                x0[r] = *(const u32x4*)(rp + lane * 8); x1[r] = *(const u32x4*)(rp + 512 + lane * 8); }
#pragma unroll
            for (int r = 0; r < 8; ++r) {
                float ss = 0.f;
#pragma unroll
                for (int e = 0; e < 4; ++e) { float p = bf_lo(x0[r][e]), q = bf_hi(x0[r][e]), r2 = bf_lo(x1[r][e]), s2 = bf_hi(x1[r][e]); ss += p * p + q * q + r2 * r2 + s2 * s2; }
#pragma unroll
                for (int o = 32; o >= 1; o >>= 1) ss += __shfl_xor(ss, o);
                if (lane == 0) rstd_s[wave * 16 + rb * 8 + r] = rsqrtf(ss * (1.0f / 1024.0f) + EPSN);
            }
        }
        __syncthreads();
        const int g = wave;
        bf16x8 Wf[20];
        {
            int idx = 0;
#pragma unroll
            for (int tt = 0; tt < 8; ++tt) {
                const int t = tt * 16 + fr;
                const float* wrow = a.w_spatial + ((size_t)g * 128 + t) * 128;
#pragma unroll
                for (int sc = 0; sc <= (tt >> 1); ++sc) {
                    const int sb = sc * 32 + 8 * fq;
                    const f32x4 a0 = *(const f32x4*)(wrow + sb), a1 = *(const f32x4*)(wrow + sb + 4);
                    float av[8];
#pragma unroll
                    for (int e = 0; e < 4; ++e) { av[e] = (sb + e <= t) ? a0[e] : 0.f; av[4 + e] = (sb + 4 + e <= t) ? a1[e] : 0.f; }
                    u32x4 ap; ap[0] = pk2(av[0], av[1]); ap[1] = pk2(av[2], av[3]); ap[2] = pk2(av[4], av[5]); ap[3] = pk2(av[6], av[7]);
                    Wf[idx++] = __builtin_bit_cast(bf16x8, ap);
                }
            }
        }
#pragma unroll 1
        for (int ch = 0; ch < 4; ++ch) {
            const int cbase = g * 128 + ch * 32;
            __syncthreads();
            {
                u32x4 raw[8];
#pragma unroll
                for (int i = 0; i < 8; ++i) { const int idx = lane + 64 * i, s = idx >> 2, cq = idx & 3;
                    raw[i] = *(const u32x4*)(w.proj + (size_t)(t0 + s) * NP + C_VA + cbase + cq * 8); }
                const int cq = lane & 3;
                const f32x4 vg0 = *(const f32x4*)(a.v_norm_g + cbase + cq * 8), vg1 = *(const f32x4*)(a.v_norm_g + cbase + cq * 8 + 4);
#pragma unroll
                for (int i = 0; i < 8; ++i) { const int s = (lane + 64 * i) >> 2; const float rs = rstd_s[s];
                    u16* vp = VT + (cq * 8) * 136 + s;
                    vp[0 * 136] = (u16)(pk2(bf_lo(raw[i][0]) * rs * vg0[0], 0.f) & 0xffffu); vp[1 * 136] = (u16)(pk2(bf_hi(raw[i][0]) * rs * vg0[1], 0.f) & 0xffffu);
                    vp[2 * 136] = (u16)(pk2(bf_lo(raw[i][1]) * rs * vg0[2], 0.f) & 0xffffu); vp[3 * 136] = (u16)(pk2(bf_hi(raw[i][1]) * rs * vg0[3], 0.f) & 0xffffu);
                    vp[4 * 136] = (u16)(pk2(bf_lo(raw[i][2]) * rs * vg1[0], 0.f) & 0xffffu); vp[5 * 136] = (u16)(pk2(bf_hi(raw[i][2]) * rs * vg1[1], 0.f) & 0xffffu);
                    vp[6 * 136] = (u16)(pk2(bf_lo(raw[i][3]) * rs * vg1[2], 0.f) & 0xffffu); vp[7 * 136] = (u16)(pk2(bf_hi(raw[i][3]) * rs * vg1[3], 0.f) & 0xffffu); }
            }
            __syncthreads();
            u32x2 uu[8][2];
#pragma unroll
            for (int tt = 0; tt < 8; ++tt) { const size_t tok = (size_t)(t0 + tt * 16 + fr);
                uu[tt][0] = *(const u32x2*)(w.proj + tok * NP + C_U + cbase + 4 * fq); uu[tt][1] = *(const u32x2*)(w.proj + tok * NP + C_U + cbase + 16 + 4 * fq); }
            {
                int idx = 0;
#pragma unroll
                for (int tt = 0; tt < 8; ++tt) {
                    f32x4 acc0 = (f32x4){0.f, 0.f, 0.f, 0.f}, acc1 = acc0;
                    const int t = tt * 16 + fr;
                    const size_t tok = (size_t)(t0 + t);
                    const float bs = a.b_spatial[g * 128 + t];
#pragma unroll
                    for (int sc = 0; sc <= (tt >> 1); ++sc) {
                        const int sb = sc * 32 + 8 * fq;
                        const bf16x8 B0 = *(const bf16x8*)(VT + fr * 136 + sb), B1 = *(const bf16x8*)(VT + (16 + fr) * 136 + sb);
                        acc0 = __builtin_amdgcn_mfma_f32_16x16x32_bf16(B0, Wf[idx], acc0, 0, 0, 0);
                        acc1 = __builtin_amdgcn_mfma_f32_16x16x32_bf16(B1, Wf[idx], acc1, 0, 0, 0);
                        ++idx;
                    }
                    const u32x2 u0 = uu[tt][0], u1 = uu[tt][1];
                    u32x2 o0, o1;
                    o0[0] = pk2(bf_lo(u0[0]) * (acc0[0] + bs), bf_hi(u0[0]) * (acc0[1] + bs)); o0[1] = pk2(bf_lo(u0[1]) * (acc0[2] + bs), bf_hi(u0[1]) * (acc0[3] + bs));
                    o1[0] = pk2(bf_lo(u1[0]) * (acc1[0] + bs), bf_hi(u1[0]) * (acc1[1] + bs)); o1[1] = pk2(bf_lo(u1[1]) * (acc1[2] + bs), bf_hi(u1[1]) * (acc1[3] + bs));
                    *(u32x2*)(w.ya + tok * 1024 + cbase + 4 * fq) = o0;
                    *(u32x2*)(w.ya + tok * 1024 + cbase + 16 + 4 * fq) = o1;
                }
            }
        }
    }
    __syncthreads();
}

DI void kv_prep_phase(const Args& a, const WS& w, unsigned char* lds) {
    const int lane = threadIdx.x & 63, wave = __builtin_amdgcn_readfirstlane(threadIdx.x >> 6);
    const int gw = blockIdx.x * 8 + wave, nw = gridDim.x * 8;
    const f32x4 kg = *(const f32x4*)(a.k_norm_g + (lane & 31) * 4);
    for (int t0 = gw; t0 < NTOK; t0 += 4 * nw) {
        u32x2 kv4[4];
#pragma unroll
        for (int q = 0; q < 4; ++q) { const int t = t0 + q * nw; kv4[q] = (t < NTOK) ? *(const u32x2*)(w.proj + (size_t)t * NP + C_K + lane * 4) : (u32x2){0u, 0u}; }
#pragma unroll
        for (int q = 0; q < 4; ++q) {
            const int t = t0 + q * nw;
            const u32x2 kv = kv4[q];
            const float v0 = bf_lo(kv[0]), v1 = bf_hi(kv[0]), v2 = bf_lo(kv[1]), v3 = bf_hi(kv[1]);
            float ss = v0 * v0 + v1 * v1 + v2 * v2 + v3 * v3;
#pragma unroll
            for (int o = 16; o >= 1; o >>= 1) ss += __shfl_xor(ss, o);
            const float rstd = rsqrtf(ss * (1.0f / 128.0f) + EPSN);
            u32x2 o; o[0] = pk2(v0 * rstd * kg[0], v1 * rstd * kg[1]); o[1] = pk2(v2 * rstd * kg[2], v3 * rstd * kg[3]);
            if (t < NTOK) *(u32x2*)(w.kn + (size_t)t * 256 + lane * 4) = o;
        }
    }
    u16* tile = (u16*)lds;
    const int tid = threadIdx.x;
    for (int item0 = blockIdx.x; item0 < NB * 32 * 4; item0 += 4 * gridDim.x) {
        __syncthreads();
        u32x4 ld[4];
#pragma unroll
        for (int q = 0; q < 4; ++q) { const int item = item0 + q * gridDim.x;
            if (item < NB * 32 * 4) { const int b = item >> 7, st = (item >> 2) & 31, dt = item & 3; const int sr = tid >> 3, dc = (tid & 7) * 8;
                ld[q] = *(const u32x4*)(w.proj + (size_t)(b * SEQ + st * 64 + sr) * NP + C_VB + dt * 64 + dc); } }
#pragma unroll
        for (int q = 0; q < 4; ++q) { const int item = item0 + q * gridDim.x;
            if (item < NB * 32 * 4) { const int sr = tid >> 3, dc = (tid & 7) * 8; *(u32x4*)(tile + q * 4608 + sr * 72 + dc) = ld[q]; } }
        __syncthreads();
#pragma unroll
        for (int q = 0; q < 4; ++q) { const int item = item0 + q * gridDim.x;
            if (item < NB * 32 * 4) { const int b = item >> 7, st = (item >> 2) & 31, dt = item & 3; const int dr = tid >> 3, sc8 = (tid & 7) * 8; u32x4 o;
#pragma unroll
                for (int e = 0; e < 4; ++e) o[e] = (u32)tile[q * 4608 + (sc8 + 2 * e) * 72 + dr] | ((u32)tile[q * 4608 + (sc8 + 2 * e + 1) * 72 + dr] << 16);
                *(u32x4*)(w.vt + ((size_t)b * 256 + dt * 64 + dr) * SEQ + st * 64 + sc8) = o; } }
    }
    __syncthreads();
}
#define MFMA32(a, b, c) __builtin_amdgcn_mfma_f32_32x32x16_bf16((a), (b), (c), 0, 0, 0)
DI float xhalf_add(float a, float b) {
    const auto r = __builtin_amdgcn_permlane32_swap(__float_as_uint(a), __float_as_uint(b), false, false);
    return __uint_as_float(r[0]) + __uint_as_float(r[1]);
}
DI float xhalf_max(float a) {
    const auto r = __builtin_amdgcn_permlane32_swap(__float_as_uint(a), __float_as_uint(a), false, false);
    return fmaxf(__uint_as_float(r[0]), __uint_as_float(r[1]));
}
DI int half_sum_dpp(int v) {
    v += __builtin_amdgcn_update_dpp(0, v, 0xB1, 0xF, 0xF, false);
    v += __builtin_amdgcn_update_dpp(0, v, 0x4E, 0xF, 0xF, false);
    v += __builtin_amdgcn_update_dpp(0, v, 0x141, 0xF, 0xF, false);
    v += __builtin_amdgcn_update_dpp(0, v, 0x140, 0xF, 0xF, false);
    v += __builtin_amdgcn_update_dpp(0, v, 0x142, 0xA, 0xF, false);
    return v;
}
constexpr int IX_SC = 131072, IX_STG = 8192;
DI void indexer_phase(const Args& a, const WS& w, unsigned char* lds) {
    const int tid = threadIdx.x, lane = tid & 63, wave = __builtin_amdgcn_readfirstlane(tid >> 6), hb = lane >> 5, l32 = lane & 31;
    float* scl = (float*)(lds + wave * 16384);
    PG8_LAS unsigned char* stg = (PG8_LAS unsigned char*)lds + IX_SC + wave * 1024;
    const unsigned char* stgr = lds + IX_SC;
    const int prow = tid >> 3, ppos = tid & 7;
    const u32 soff = (u32)prow * (u32)(NP * 2) + (u32)((ppos ^ ((prow >> 1) & 7)) * 16);
    const int bfo = l32 * 128, bx = (l32 >> 1) & 7;
    const float idx_scale = 0.125f * 0.25f;
    int r = 0;
    bf16x8 Afn[4]; u32x2 wrn[4];
#define IX_LOAD_ITEM(itv, rv) do { const int _b = (itv) >> 7; int _ib = (itv) & 127; if ((rv) & 1) _ib = 127 - _ib; const int _t0 = _b * SEQ + _ib * 16 + 2 * wave; \
        const u16* _qp = w.proj + (size_t)(_t0 + (l32 >> 4)) * NP + C_QI + (l32 & 15) * 64 + 8 * hb; \
        _Pragma("unroll") for (int kk = 0; kk < 4; ++kk) Afn[kk] = *(const bf16x8*)(_qp + 16 * kk); \
        const u16* _wp = w.proj + (size_t)_t0 * NP + C_WI + 4 * hb; \
        wrn[0] = *(const u32x2*)_wp; wrn[1] = *(const u32x2*)(_wp + 8); wrn[2] = *(const u32x2*)(_wp + NP); wrn[3] = *(const u32x2*)(_wp + NP + 8); } while (0)
    if ((int)blockIdx.x < NTOK / 16) IX_LOAD_ITEM((int)blockIdx.x, 0);
    if (wave >= 4) __builtin_amdgcn_s_setprio(1);
    for (int it0 = blockIdx.x; it0 < NTOK / 16; it0 += gridDim.x, ++r) {
        const int b = it0 >> 7; int ib = it0 & 127; if (r & 1) ib = 127 - ib;
        const int p0 = ib * 16 + 2 * wave, t0 = b * SEQ + p0;
        const int jmax = ib >> 1, nst = (jmax >> 1) + 1;
        const char* kbase = (const char*)(w.proj + (size_t)b * SEQ * NP + C_KI);
#define IX_STAGE(stage) __builtin_amdgcn_global_load_lds((const unsigned*)(kbase + (size_t)(stage) * 64 * (NP * 2) + soff), (PG8_LAS unsigned*)(stg + ((stage) % 3) * IX_STG), 16, 0, 0)
        bf16x8 Af[4];
#pragma unroll
        for (int kk = 0; kk < 4; ++kk) Af[kk] = Afn[kk];
        float wv0[8], wv1[8];
        wv0[0] = bf_lo(wrn[0][0]) * idx_scale; wv0[1] = bf_hi(wrn[0][0]) * idx_scale; wv0[2] = bf_lo(wrn[0][1]) * idx_scale; wv0[3] = bf_hi(wrn[0][1]) * idx_scale;
        wv0[4] = bf_lo(wrn[1][0]) * idx_scale; wv0[5] = bf_hi(wrn[1][0]) * idx_scale; wv0[6] = bf_lo(wrn[1][1]) * idx_scale; wv0[7] = bf_hi(wrn[1][1]) * idx_scale;
        wv1[0] = bf_lo(wrn[2][0]) * idx_scale; wv1[1] = bf_hi(wrn[2][0]) * idx_scale; wv1[2] = bf_lo(wrn[2][1]) * idx_scale; wv1[3] = bf_hi(wrn[2][1]) * idx_scale;
        wv1[4] = bf_lo(wrn[3][0]) * idx_scale; wv1[5] = bf_hi(wrn[3][0]) * idx_scale; wv1[6] = bf_lo(wrn[3][1]) * idx_scale; wv1[7] = bf_hi(wrn[3][1]) * idx_scale;
        asm volatile("s_waitcnt vmcnt(0)" ::: "memory");
        __builtin_amdgcn_s_barrier();
        asm volatile("" ::: "memory");
        IX_STAGE(0);
        if (nst > 1) IX_STAGE(1);
        for (int st = 0; st < nst; ++st) {
            if (st + 1 < nst) asm volatile("s_waitcnt vmcnt(1)" ::: "memory"); else asm volatile("s_waitcnt vmcnt(0)" ::: "memory");
            __builtin_amdgcn_s_barrier();
            asm volatile("" ::: "memory");
            if (st + 2 < nst) IX_STAGE(st + 2);
            const unsigned char* sb = stgr + (st % 3) * IX_STG + bfo;
#define IX_SUB(sub) { const int j = 2 * st + (sub); \
                f32x16 cacc; \
                _Pragma("unroll") for (int i = 0; i < 16; ++i) cacc[i] = 0.f; \
                _Pragma("unroll") for (int kk = 0; kk < 4; ++kk) cacc = MFMA32(Af[kk], *(const bf16x8*)(sb + (sub) * 4096 + (((2 * kk + hb) ^ bx) << 4)), cacc); \
                float s0 = 0.f, s1 = 0.f; \
                _Pragma("unroll") for (int i = 0; i < 8; ++i) { s0 += wv0[i] * fmaxf(cacc[i], 0.f); s1 += wv1[i] * fmaxf(cacc[8 + i], 0.f); } \
                const float mine = xhalf_add(s0, s1); \
                scl[hb * 2048 + j * 32 + l32] = mine; }
            if (2 * st + 1 <= jmax) { IX_SUB(0) IX_SUB(1) } else { IX_SUB(0) }
        }
        asm volatile("s_waitcnt lgkmcnt(0)" ::: "memory");
        if (it0 + (int)gridDim.x < NTOK / 16) IX_LOAD_ITEM(it0 + (int)gridDim.x, r + 1);
        const int pl = p0 + hb;
        u32 uk[64];
#pragma unroll
        for (int j = 0; j < 64; ++j) {
            const int key = j * 32 + l32;
            const u32 u = __float_as_uint(scl[hb * 2048 + key]);
            const u32 s = u ^ (u32)(((int)u >> 31) | (int)0x80000000);
            uk[j] = (key <= pl) ? s : 0u;
            __builtin_amdgcn_sched_barrier(0);
        }
        asm volatile("s_waitcnt lgkmcnt(0)" ::: "memory");
        u32 T0 = 0u, T1 = 0u; bool done0 = (p0 + 1 <= 256), done1 = (p0 + 2 <= 256);
        if (done0) T0 = 1u; if (done1) T1 = 1u;
        for (int bit = 31; bit >= 0; --bit) {
            if (done0 && done1) break;
            const u32 c0 = T0 | (1u << bit), c1 = T1 | (1u << bit);
            const u32 cv = hb ? c1 : c0;
            int cnt = 0;
#pragma unroll
            for (int j = 0; j < 16; ++j) cnt += (uk[j] >= cv) ? 1 : 0;
            if (jmax >= 16) {
#pragma unroll
                for (int j = 16; j < 32; ++j) cnt += (uk[j] >= cv) ? 1 : 0;
            }
            if (jmax >= 32) {
#pragma unroll
                for (int j = 32; j < 48; ++j) cnt += (uk[j] >= cv) ? 1 : 0;
            }
            if (jmax >= 48) {
#pragma unroll
                for (int j = 48; j < 64; ++j) cnt += (uk[j] >= cv) ? 1 : 0;
            }
            cnt = half_sum_dpp(cnt);
            const int n0 = __builtin_amdgcn_readlane(cnt, 31), n1 = __builtin_amdgcn_readlane(cnt, 63);
            if (!done0) { if (n0 >= 256) T0 = c0; if (n0 == 256) done0 = true; }
            if (!done1) { if (n1 >= 256) T1 = c1; if (n1 == 256) done1 = true; }
        }
        const u32 Tv = hb ? T1 : T0;
        int gcnt = 0;
#pragma unroll
        for (int j = 0; j < 64; ++j) gcnt += (uk[j] > Tv) ? 1 : 0;
        gcnt = half_sum_dpp(gcnt);
        const int g0 = __builtin_amdgcn_readlane(gcnt, 31), g1 = __builtin_amdgcn_readlane(gcnt, 63);
        u32 w0 = 0u, w1 = 0u;
        int lz = lane; asm volatile("" : "+v"(lz));
        if (done0 && done1) {
#pragma unroll
            for (int j = 0; j < 64; ++j) {
                const unsigned long long bs = __ballot(uk[j] >= Tv);
                w0 = (lz == j) ? (u32)bs : w0; w1 = (lz == j) ? (u32)(bs >> 32) : w1;
                __builtin_amdgcn_sched_barrier(0);
            }
        } else {
            const int need0 = done0 ? 0x7fffffff : 256 - g0, need1 = done1 ? 0x7fffffff : 256 - g1;
            const int need = hb ? need1 : need0;
            int run0 = 0, run1 = 0;
            const u32 ltmask = (1u << l32) - 1u;
#pragma unroll
            for (int j = 0; j < 64; ++j) {
                const bool eq = (uk[j] == Tv);
                const unsigned long long be = __ballot(eq);
                const u32 mybe = hb ? (u32)(be >> 32) : (u32)be;
                const int rank = (hb ? run1 : run0) + __popc(mybe & ltmask);
                const bool sel = (uk[j] > Tv) || (eq && rank < need);
                run0 += __popc((u32)be); run1 += __popc((u32)(be >> 32));
                const unsigned long long bs = __ballot(sel);
                w0 = (lz == j) ? (u32)bs : w0; w1 = (lz == j) ? (u32)(bs >> 32) : w1;
                __builtin_amdgcn_sched_barrier(0);
            }
        }
        w.mask[(size_t)t0 * 64 + lane] = w0; w.mask[(size_t)(t0 + 1) * 64 + lane] = w1;
    }
    if (wave >= 4) __builtin_amdgcn_s_setprio(0);
    __syncthreads();
}

constexpr int AT_KROW = 256, AT_VROW = 128, AT_KBYTES = 64 * AT_KROW, AT_STAGE = AT_KBYTES + 128 * AT_VROW;
DI void attn_item(const Args& a, const WS& w, unsigned char* lds, int b, int g, int qb) {
    const int tid = threadIdx.x, lane = tid & 63, wave = __builtin_amdgcn_readfirstlane(tid >> 6), hb = lane >> 5, l32 = lane & 31;
    const int h = 4 * g + (wave & 3), qsub = wave >> 2, q0 = qb * 64 + qsub * 32;
    const size_t tq = (size_t)b * SEQ + q0 + l32;
    bf16x8 qf[8]; float nq2 = 0.f;
    { const u16* qp = w.proj + tq * NP + C_Q + h * 128 + 8 * hb;
      float ss = 0.f;
#pragma unroll
      for (int kk = 0; kk < 8; ++kk) { const u32x4 raw = *(const u32x4*)(qp + 16 * kk);
#pragma unroll
          for (int e = 0; e < 4; ++e) { const float lo = bf_lo(raw[e]), hi = bf_hi(raw[e]); ss += lo * lo + hi * hi; } }
      ss += __shfl_xor(ss, 32);
      const float sc = rsqrtf(ss * (1.0f / 128.0f) + EPSN) * 0.08838834764831845f * 1.44269504089f;
#pragma unroll
      for (int kk = 0; kk < 8; ++kk) { const u32x4 raw = *(const u32x4*)(qp + 16 * kk);
          const f32x4 g0 = *(const f32x4*)(a.q_norm_g + 16 * kk + 8 * hb), g1 = *(const f32x4*)(a.q_norm_g + 16 * kk + 8 * hb + 4);
          u32x4 o;
          o[0] = pk2(bf_lo(raw[0]) * sc * g0[0], bf_hi(raw[0]) * sc * g0[1]); o[1] = pk2(bf_lo(raw[1]) * sc * g0[2], bf_hi(raw[1]) * sc * g0[3]);
          o[2] = pk2(bf_lo(raw[2]) * sc * g1[0], bf_hi(raw[2]) * sc * g1[1]); o[3] = pk2(bf_lo(raw[3]) * sc * g1[2], bf_hi(raw[3]) * sc * g1[3]);
          qf[kk] = __builtin_bit_cast(bf16x8, o);
#pragma unroll
          for (int e = 0; e < 4; ++e) { const float lo = bf_lo(o[e]), hi = bf_hi(o[e]); nq2 += lo * lo + hi * hi; }
          __builtin_amdgcn_sched_barrier(0); } }
    float mfix;
    { float gm = fmaxf(fabsf(a.k_norm_g[lane]), fabsf(a.k_norm_g[lane + 64]));
#pragma unroll
      for (int o = 32; o >= 1; o >>= 1) gm = fmaxf(gm, __shfl_xor(gm, o));
      const float nq = xhalf_add(nq2, nq2);
      mfix = sqrtf(nq) * 11.3137085f * gm * 1.004f; }
    f32x16 o[4];
#pragma unroll
    for (int d = 0; d < 4; ++d)
#pragma unroll
        for (int i = 0; i < 16; ++i) o[d][i] = 0.f;
    float lsum = 0.f;
    const int rperm = (l32 & 0x13) | ((l32 & 4) << 1) | ((l32 & 8) >> 1);
    const int p0 = tid, p1 = tid + 512;
    const char* kbase = (const char*)(w.kn + (size_t)b * SEQ * 256 + g * 128);
    const char* vbase = (const char*)(w.vt + ((size_t)b * 256 + g * 128) * SEQ);
    const u32 ko0 = (u32)(((p0 >> 4) * 256 + (((p0 & 15) ^ ((p0 >> 4) & 15)) * 8)) * 2), ko1 = (u32)(((p1 >> 4) * 256 + (((p1 & 15) ^ ((p1 >> 4) & 15)) * 8)) * 2);
    const u32 vo0 = (u32)(((p0 >> 3) * SEQ + (((p0 & 7) ^ ((p0 >> 4) & 7)) * 8)) * 2), vo1 = (u32)(((p1 >> 3) * SEQ + (((p1 & 7) ^ ((p1 >> 4) & 7)) * 8)) * 2);
    PG8_LAS unsigned char* ldsw = (PG8_LAS unsigned char*)lds + wave * 1024;
#define AT_STAGE_TILE(bufo, ktile) do { const char* _kb = kbase + (size_t)(ktile) * 64 * 512; const char* _vb = vbase + (size_t)(ktile) * 128; \
        __builtin_amdgcn_global_load_lds((const unsigned*)(_kb + ko0), (PG8_LAS unsigned*)(ldsw + (bufo)), 16, 0, 0); \
        __builtin_amdgcn_global_load_lds((const unsigned*)(_kb + ko1), (PG8_LAS unsigned*)(ldsw + (bufo) + 8192), 16, 0, 0); \
        __builtin_amdgcn_global_load_lds((const unsigned*)(_vb + vo0), (PG8_LAS unsigned*)(ldsw + (bufo) + AT_KBYTES), 16, 0, 0); \
        __builtin_amdgcn_global_load_lds((const unsigned*)(_vb + vo1), (PG8_LAS unsigned*)(ldsw + (bufo) + AT_KBYTES + 8192), 16, 0, 0); } while (0)
    const u32* mp = w.mask + tq * 64;
    const int r15 = rperm & 15, kfo = rperm * AT_KROW, vx = (l32 >> 1) & 7, vfo = AT_KBYTES + l32 * AT_VROW;
    u32x2 mwn = *(const u32x2*)mp;
    AT_STAGE_TILE(0, 0);
    if (qb >= 1) { AT_STAGE_TILE(AT_STAGE, 1); asm volatile("s_waitcnt vmcnt(4)" ::: "memory"); } else { asm volatile("s_waitcnt vmcnt(0)" ::: "memory"); }
    __builtin_amdgcn_s_barrier();
    asm volatile("" ::: "memory");
    if (wave >= 4) __builtin_amdgcn_s_setprio(1);
    for (int kt = 0; kt <= qb; ++kt) {
        const unsigned char* buf = lds + (kt % 3) * AT_STAGE;
        const u32x2 mwc = mwn;
        if (kt < qb) mwn = *(const u32x2*)(mp + 2 * (kt + 1));
        if (kt + 2 <= qb) { AT_STAGE_TILE(((kt + 2) % 3) * AT_STAGE, kt + 2); }
        const bool two = !(kt == qb && qsub == 0);
        const unsigned char* kb = buf + kfo;
        const unsigned char* vb = buf + vfo;
#define AT_QK(sv, sub) { _Pragma("unroll") for (int i = 0; i < 16; ++i) sv[i] = 0.f; \
            _Pragma("unroll") for (int kk = 0; kk < 8; ++kk) sv = MFMA32(*(const bf16x8*)(kb + (sub) * 32 * AT_KROW + (((2 * kk + hb) ^ r15) << 4)), qf[kk], sv); }
#define AT_SM(sv, pfv, sub) { const u32 mw0 = ((sub) ? mwc[1] : mwc[0]) >> (8 * hb); \
            _Pragma("unroll") for (int i = 0; i < 16; ++i) { const int bit = 16 * (i >> 3) + (i & 7); const float p = __builtin_amdgcn_exp2f(sv[i] - mfix); sv[i] = ((mw0 >> bit) & 1u) ? p : 0.f; lsum += sv[i]; if ((i & 3) == 3) __builtin_amdgcn_sched_barrier(0); } \
            _Pragma("unroll") for (int k2 = 0; k2 < 2; ++k2) { u32x4 pp; \
                _Pragma("unroll") for (int e = 0; e < 4; ++e) pp[e] = pk2(sv[8 * k2 + 2 * e], sv[8 * k2 + 2 * e + 1]); \
                pfv[k2] = __builtin_bit_cast(bf16x8, pp); } }
#define AT_PV(pfv, sub) { _Pragma("unroll") for (int d = 0; d < 4; ++d) \
                _Pragma("unroll") for (int k2 = 0; k2 < 2; ++k2) o[d] = MFMA32(*(const bf16x8*)(vb + d * 32 * AT_VROW + (((4 * (sub) + 2 * k2 + hb) ^ vx) << 4)), pfv[k2], o[d]); }
        const int nsub = two ? 2 : 1;
#pragma unroll 1
        for (int sub = 0; sub < nsub; ++sub) {
            f32x16 sa; bf16x8 pfa[2];
            _Pragma("unroll") for (int i = 0; i < 16; ++i) sa[i] = 0.f;
            _Pragma("unroll") for (int kk = 0; kk < 8; ++kk) sa = MFMA32(*(const bf16x8*)(kb + sub * 32 * AT_KROW + (((2 * kk + hb) ^ r15) << 4)), qf[kk], sa);
            const u32 mw0 = (sub ? mwc[1] : mwc[0]) >> (8 * hb);
            _Pragma("unroll") for (int i = 0; i < 16; ++i) { const int bit = 16 * (i >> 3) + (i & 7); const float p = __builtin_amdgcn_exp2f(sa[i] - mfix); sa[i] = ((mw0 >> bit) & 1u) ? p : 0.f; lsum += sa[i]; }
            _Pragma("unroll") for (int k2 = 0; k2 < 2; ++k2) { u32x4 pp;
                _Pragma("unroll") for (int e = 0; e < 4; ++e) pp[e] = pk2(sa[8 * k2 + 2 * e], sa[8 * k2 + 2 * e + 1]);
                pfa[k2] = __builtin_bit_cast(bf16x8, pp); }
            const int vsw = 4 * sub;
            _Pragma("unroll") for (int d = 0; d < 4; ++d)
                _Pragma("unroll") for (int k2 = 0; k2 < 2; ++k2) o[d] = MFMA32(*(const bf16x8*)(vb + d * 32 * AT_VROW + (((vsw + 2 * k2 + hb) ^ vx) << 4)), pfa[k2], o[d]);
        }
        if (kt + 2 <= qb) asm volatile("s_waitcnt vmcnt(4)" ::: "memory"); else asm volatile("s_waitcnt vmcnt(0)" ::: "memory");
        asm volatile("s_waitcnt lgkmcnt(0)" ::: "memory");
        __builtin_amdgcn_s_barrier();
        asm volatile("" ::: "memory");
    }
    if (wave >= 4) __builtin_amdgcn_s_setprio(0);
    lsum += __shfl_xor(lsum, 32);
    const float inv = 1.0f / lsum;
    u16* op = w.yb + tq * 1024 + h * 128 + 4 * hb;
#pragma unroll
    for (int d = 0; d < 4; ++d)
#pragma unroll
        for (int i4 = 0; i4 < 4; ++i4) { u32x2 ov; ov[0] = pk2(o[d][4 * i4] * inv, o[d][4 * i4 + 1] * inv); ov[1] = pk2(o[d][4 * i4 + 2] * inv, o[d][4 * i4 + 3] * inv);
            *(u32x2*)(op + 32 * d + 8 * i4) = ov; }
}
DI void attn_phase(const Args& a, const WS& w, unsigned char* lds, int cid) {
    if (gridDim.x == 256) {
        const int xcd = cid & 7, bx = cid >> 3, bl = bx & 3, x = bx >> 2;
        for (int r = 0; r < 4; ++r) { const int qb = (r & 1) ? (31 - 8 * r - (7 - x)) : (31 - 8 * r - x); attn_item(a, w, lds, 2 * xcd + (bl >> 1), bl & 1, qb); }
    } else {
        for (int t = blockIdx.x; t < NB * 2 * 32; t += gridDim.x) attn_item(a, w, lds, (t & 31) >> 1, t & 1, 31 - (t >> 5));
    }
}

DI void convfix_phase(const Args& a, const WS& w) {
    const int nth = gridDim.x * 512;
    for (int task = blockIdx.x * 512 + threadIdx.x; task < (NTOK / 64) * (DFF / 8); task += nth) {
        const int q = task / (DFF / 8), ch = task % (DFF / 8), n0 = ch * 8;
        if ((q & 31) == 0) continue;
        float xa[4][8], xb[4][8];
#pragma unroll
        for (int sl = 0; sl < 4; ++sl) { const u16* hp = w.halo + ((size_t)q * 4 + sl) * NUP + n0; const u32x4 pa = *(const u32x4*)hp, pb = *(const u32x4*)(hp + DFF);
#pragma unroll
            for (int e = 0; e < 4; ++e) { xa[sl][2 * e] = bf_lo(pa[e]); xa[sl][2 * e + 1] = bf_hi(pa[e]); xb[sl][2 * e] = bf_lo(pb[e]); xb[sl][2 * e + 1] = bf_hi(pb[e]); } }
#pragma unroll
        for (int rr = 0; rr < 2; ++rr) {
            float res[8];
#pragma unroll
            for (int e = 0; e < 8; ++e) {
                const float ya = a.conv_b[n0 + e] + a.conv_w[n0 + e] * xa[rr][e] + a.conv_w[NUP + n0 + e] * xa[rr + 1][e] + a.conv_w[2 * NUP + n0 + e] * xa[rr + 2][e];
                const float yb = a.conv_b[DFF + n0 + e] + a.conv_w[DFF + n0 + e] * xb[rr][e] + a.conv_w[NUP + DFF + n0 + e] * xb[rr + 1][e] + a.conv_w[2 * NUP + DFF + n0 + e] * xb[rr + 2][e];
                res[e] = silu_f(ya) * yb;
            }
            u32x4 o; o[0] = pk2(res[0], res[1]); o[1] = pk2(res[2], res[3]); o[2] = pk2(res[4], res[5]); o[3] = pk2(res[6], res[7]);
            *(u32x4*)(w.act + (size_t)(q * 64 + rr) * DFF + n0) = o;
        }
    }
}

__global__ void __launch_bounds__(512, 2) fwd_mega(Args a) {
    extern __shared__ __attribute__((aligned(16))) unsigned char shm[];
    cg::grid_group grid = cg::this_grid();
    const WS w = make_ws(a.ws);
    const int lo = a.ph_lo, hi = a.ph_hi; const bool coop = a.coop != 0;
    volatile XLAS unsigned* xst = (volatile XLAS unsigned*)((XLAS unsigned char*)shm + LDS_BAR_OFF);
    if (threadIdx.x == 0) { xst[0] = 0u; xst[1] = 0u; xst[2] = 0u; xst[3] = 0u; }
    __syncthreads();
    XcdBarrier xb; xb.bar = (unsigned*)(a.ws + WS_BAR); xb.x = 0u; xb.st = xst;
    if (coop) xb = xcd_barrier_post((unsigned*)(a.ws + WS_BAR), xst);
    int cid = (int)blockIdx.x;
    if (coop) {
        if (threadIdx.x == 0) {
            unsigned* bar = (unsigned*)(a.ws + WS_BAR);
            const unsigned G = gridDim.x, x = xb.x;
            const unsigned my = xb_add(&bar[4 * x], 1u);
            unsigned sum = 0u, sp = 0u; bool ok = true;
            for (;;) {
                sum = 0u; ok = ((G & 7u) == 0u);
#pragma unroll
                for (unsigned j = 0; j < 16; ++j) { const unsigned c = xb_ld(&bar[4 * j]); sum += c; if (j < 8 ? (c != G / 8u) : (c != 0u)) ok = false; }
                if (sum == G) break;
                __builtin_amdgcn_s_sleep(1);
                if (++sp > (1u << 20)) { ok = false; break; }
            }
            xst[2] = ok ? (my * 8u + x) : blockIdx.x;
            xst[3] = ok ? 1u : 0u;
        }
        __syncthreads();
        cid = (int)xst[2];
    }
    if (a.pad == 0x5eed) grid.sync();
#ifndef DUP
#define DUP -1
#endif
#ifndef PROBE_PH
#define PROBE_PH -1
#endif
#define REP(n) for (int _r = 0; _r < ((n) == DUP ? 2 : 1); ++_r)
#define PH_BEGIN(n) if (lo <= (n) && (n) < hi) { REP(n) {
#define PH_END(n) } if (coop && (n) + 1 < hi) xcd_barrier(xb); }
    PH_BEGIN(0) phase0(a, w, shm); PH_END(0)
    PH_BEGIN(1) rms_phase<false>(a, w, shm, a.x, a.norm1_g, 0, 2048, w.hbuf, true); PH_END(1)
    PH_BEGIN(2) { const int nrep = (PROBE_PH == 2) ? a.pad : 1;
#pragma unroll 1
    for (int rp = 0; rp < nrep; ++rp) { EpiProj E; E.O = w.proj; run_gemm(shm, w.hbuf, w.wt_in, NTOK, NP, 2048, E, cid); } } convert_wup_tail(a, w, shm, cid); PH_END(2)
    PH_BEGIN(3) REP(30) mixer_a_phase(a, w, shm); REP(31) kv_prep_phase(a, w, shm); REP(32) indexer_phase(a, w, shm); PH_END(3)
    PH_BEGIN(4) attn_phase(a, w, shm, cid); PH_END(4)
    PH_BEGIN(5) { EpiGate E; E.T = w.merged; E.proj = w.proj; E.gcol = C_GA; E.first = 1; run_gemm(shm, w.ya, w.wt_a, NTOK, 2048, 1024, E, cid);
                  EpiGate E2; E2.T = w.merged; E2.proj = w.proj; E2.gcol = C_GB; E2.first = 0; run_gemm(shm, w.yb, w.wt_b, NTOK, 2048, 1024, E2, cid); } PH_END(5)
    PH_BEGIN(6) { EpiResB E; E.O = w.x1b; E.R = a.x; E.mod = w.mod; E.goff = 4096; run_gemm(shm, w.merged, w.wt_out, NTOK, 2048, 2048, E, cid); } PH_END(6)
    PH_BEGIN(7) rms_phase<true>(a, w, shm, w.x1b, a.norm2_g, 6144, 8192, w.hbuf, false); PH_END(7)
    PH_BEGIN(8) { const int nrep = (PROBE_PH == 8) ? a.pad : 1;
#pragma unroll 1
    for (int rp = 0; rp < nrep; ++rp) { EpiConv E; E.act = w.act; E.halo = w.halo; E.cw = a.conv_w; E.cb = a.conv_b; run_gemm(shm, w.hbuf, w.wt_up, NTOK, NUP, 2048, E, cid); } } PH_END(8)
    PH_BEGIN(9) convfix_phase(a, w); PH_END(9)
    PH_BEGIN(10) { const int nrep = (PROBE_PH == 10) ? a.pad : 1;
#pragma unroll 1
    for (int rp = 0; rp < nrep; ++rp) { EpiOut E; E.O = a.out; E.R = w.x1b; E.mod = w.mod; E.goff = 10240; run_gemm(shm, w.act, w.wt_dn, NTOK, 2048, DFF, E, cid); } } PH_END(10)
}

extern "C" void kernel_launch(void* const* d_in, const int* in_sizes, int n_in, void* d_out, int out_size, void* d_ws, size_t ws_size, hipStream_t stream) {
    static int grid = 0;
    if (grid == 0) {
        int dev = 0, cus = 0, per_cu = 0;
        hipGetDevice(&dev); hipDeviceGetAttribute(&cus, hipDeviceAttributeMultiprocessorCount, dev);
        if (hipFuncSetAttribute((const void*)fwd_mega, hipFuncAttributeMaxDynamicSharedMemorySize, LDS_BYTES) != hipSuccess) fprintf(stderr, "kernel_launch: hipFuncSetAttribute failed\n");
        hipOccupancyMaxActiveBlocksPerMultiprocessor(&per_cu, (const void*)fwd_mega, 512, LDS_BYTES);
        (void)hipGetLastError();
        if (per_cu < 1) per_cu = 1;
        grid = cus * 1;
        if (ws_size < WS_END) fprintf(stderr, "kernel_launch: workspace too small: %zu < %zu\n", ws_size, (size_t)WS_END);
        fprintf(stderr, "kernel_launch: cus %d per_cu %d grid %d ws %zu need %zu\n", cus, per_cu, grid, ws_size, (size_t)WS_END);
    }
    Args a{};
    a.x = (const float*)d_in[0]; a.c = (const float*)d_in[1]; a.w_ada = (const float*)d_in[2]; a.b_ada = (const float*)d_in[3]; a.norm1_g = (const float*)d_in[4]; a.w_in = (const float*)d_in[5];
    a.v_norm_g = (const float*)d_in[6]; a.w_spatial = (const float*)d_in[7]; a.b_spatial = (const float*)d_in[8]; a.q_norm_g = (const float*)d_in[9]; a.k_norm_g = (const float*)d_in[10];
    a.w_proj_a = (const float*)d_in[11]; a.w_proj_b = (const float*)d_in[12]; a.w_out = (const float*)d_in[13]; a.norm2_g = (const float*)d_in[14]; a.w_up = (const float*)d_in[15];
    a.conv_w = (const float*)d_in[16]; a.conv_b = (const float*)d_in[17]; a.w_down = (const float*)d_in[18];
    a.out = (float*)d_out; a.ws = (unsigned char*)d_ws;
#if MULTI_LAUNCH
    a.coop = 0;
    for (int ph = 0; ph < NPH; ++ph) { a.ph_lo = ph; a.ph_hi = ph + 1; hipLaunchKernelGGL(fwd_mega, dim3(grid), dim3(512), LDS_BYTES, stream, a); }
#else
    a.coop = 1; a.ph_lo = 0; a.ph_hi = NPH; a.pad = (PROBE_PH >= 0) ? 2 : 0;
    if (hipMemsetAsync((unsigned char*)d_ws + WS_BAR, 0, XCD_BAR_WORDS * 4, stream) != hipSuccess) fprintf(stderr, "kernel_launch: memset of barrier words failed\n");
    void* args[] = {&a};
    hipError_t e = hipLaunchCooperativeKernel((const void*)fwd_mega, dim3(grid), dim3(512), args, LDS_BYTES, stream);
    if (e != hipSuccess) fprintf(stderr, "cooperative launch failed: %s (grid %d)\n", hipGetErrorString(e), grid);
#endif
}
```
